# Optimizing an MI355X kernel written in HIP

```python
import jax, jax.numpy as jnp
from jax import lax
import numpy as np

D_MODEL = 1024
BATCH = 8
SEQ = 4096
DEPTH = 4

N_MIXERS = 2
N_A = (DEPTH + 1) // 2
N_B = DEPTH // 2
WIDTH = 3 * D_MODEL // 2
LRU_HEADS = 12
LRU_BLOCK = WIDTH // LRU_HEADS
CONV_A = 4
CONV_B = 3
LRU_C = 8.0
NORM_EPS = 1e-6

kernel_name = "hybrid_rglru_shortconv_trunk"


def rmsnorm(x, g):
    xf = x.astype(jnp.float32)
    inv = lax.rsqrt(jnp.mean(xf * xf, axis=-1, keepdims=True) + NORM_EPS)
    return (xf * inv * g.astype(jnp.float32)).astype(x.dtype)


def causal_depthwise_conv(u, w, b=None):
    k_width = w.shape[0]
    s = u.shape[1]
    up = jnp.pad(u, ((0, 0), (k_width - 1, 0), (0, 0)))
    out = up[:, 0:s] * w[0]
    for k in range(1, k_width):
        out = out + up[:, k:k + s] * w[k]
    if b is not None:
        out = out + b
    return out


def rg_lru(u, gate_w, gate_b, lam):
    bsz, s, w = u.shape
    uh = u.reshape(bsz, s, LRU_HEADS, LRU_BLOCK)
    g = jnp.einsum('bshi,hio->bsho', uh, gate_w) + gate_b
    g = jax.nn.sigmoid(g.astype(jnp.float32))
    r = g[..., :LRU_BLOCK].reshape(bsz, s, w)
    i = g[..., LRU_BLOCK:].reshape(bsz, s, w)
    log_a = -LRU_C * r * jax.nn.softplus(-lam.astype(jnp.float32))
    a = jnp.exp(log_a)
    mult = jnp.sqrt(-jnp.expm1(2.0 * log_a))
    bterm = mult * (i * u.astype(jnp.float32))

    def combine(left, right):
        a_l, b_l = left
        a_r, b_r = right
        return a_l * a_r, a_r * b_l + b_r

    _, h = lax.associative_scan(combine, (a, bterm), axis=1)
    return h.astype(u.dtype)


def recurrent_mixer(h, w_in, conv_w, conv_b, gate_w, gate_b, lam, w_out):
    u = jnp.einsum('bsd,dc->bsc', h, w_in)
    gate, xb = u[..., :WIDTH], u[..., WIDTH:]
    xb = causal_depthwise_conv(xb, conv_w, conv_b)
    y = rg_lru(xb, gate_w, gate_b, lam)
    return jnp.einsum('bsc,cd->bsd', y * jax.nn.silu(gate), w_out)


def shortconv_mixer(h, w_in, conv_w, w_out):
    u = jnp.einsum('bsd,dc->bsc', h, w_in)
    bg = u[..., :WIDTH]
    cg = u[..., WIDTH:2 * WIDTH]
    xv = u[..., 2 * WIDTH:3 * WIDTH]
    gate = u[..., 3 * WIDTH:]
    y = bg * causal_depthwise_conv(cg * xv, conv_w)
    return jnp.einsum('bsc,cd->bsd', y * jax.nn.silu(gate), w_out)


def setup_inputs(seed: int = 0) -> dict:
    key = jax.random.key(seed)
    ks = jax.random.split(key, 16)
    f32 = jnp.float32
    x = jax.random.normal(ks[0], (BATCH, SEQ, D_MODEL), f32)
    norm_g = 1.0 + 0.02 * jax.random.normal(ks[1], (DEPTH, D_MODEL), f32)
    a_w_in = jax.random.normal(ks[2], (N_A, D_MODEL, 2 * WIDTH), f32) * D_MODEL ** -0.5
    a_conv_w = jax.random.normal(ks[3], (N_A, CONV_A, WIDTH), f32) * CONV_A ** -0.5
    a_conv_b = 0.02 * jax.random.normal(ks[4], (N_A, WIDTH), f32)
    a_gate_w = jax.random.normal(ks[5], (N_A, LRU_HEADS, LRU_BLOCK, 2 * LRU_BLOCK), f32) * LRU_BLOCK ** -0.5
    a_gate_b = 0.02 * jax.random.normal(ks[6], (N_A, LRU_HEADS, 2 * LRU_BLOCK), f32)
    a0 = jax.random.uniform(ks[7], (N_A, WIDTH), f32, minval=0.9, maxval=0.999)
    a_lambda = jnp.log(a0) - jnp.log1p(-a0)
    a_w_out = jax.random.normal(ks[8], (N_A, WIDTH, D_MODEL), f32) * WIDTH ** -0.5
    b_w_in = jax.random.normal(ks[9], (N_B, D_MODEL, 4 * WIDTH), f32) * D_MODEL ** -0.5
    b_conv_w = jax.random.normal(ks[10], (N_B, CONV_B, WIDTH), f32) * CONV_B ** -0.5
    b_w_out = jax.random.normal(ks[11], (N_B, WIDTH, D_MODEL), f32) * WIDTH ** -0.5
    final_g = 1.0 + 0.02 * jax.random.normal(ks[12], (D_MODEL,), f32)
    return {"x": x, "norm_g": norm_g, "a_w_in": a_w_in, "a_conv_w": a_conv_w,
            "a_conv_b": a_conv_b, "a_gate_w": a_gate_w, "a_gate_b": a_gate_b,
            "a_lambda": a_lambda, "a_w_out": a_w_out, "b_w_in": b_w_in,
            "b_conv_w": b_conv_w, "b_w_out": b_w_out, "final_g": final_g}


def reference(x, norm_g, a_w_in, a_conv_w, a_conv_b, a_gate_w, a_gate_b, a_lambda,
              a_w_out, b_w_in, b_conv_w, b_w_out, final_g):
    for i in range(DEPTH):
        h = rmsnorm(x, norm_g[i])
        j = i // N_MIXERS
        if i % N_MIXERS == 0:
            x = x + recurrent_mixer(h, a_w_in[j], a_conv_w[j], a_conv_b[j], a_gate_w[j],
                                    a_gate_b[j], a_lambda[j], a_w_out[j])
        else:
            x = x + shortconv_mixer(h, b_w_in[j], b_conv_w[j], b_w_out[j])
    return rmsnorm(x, final_g)
```

```cpp
#include <hip/hip_runtime.h>
#include <hip/hip_cooperative_groups.h>
#include <cstdio>
#include <cstdint>
namespace pg8 {
#define PG8_LAS __attribute__((address_space(3)))
typedef unsigned short bf16_t;
typedef short bf16x8 __attribute__((ext_vector_type(8)));
typedef float f32x4 __attribute__((ext_vector_type(4)));
typedef unsigned u32x4 __attribute__((ext_vector_type(4)));
constexpr int BM = 256, BK = 64, HALF = 128, HTB = HALF * BK * 2  , STAGE_BYTES = 8 * HTB, NXCD = 8, WGM = 8;

__host__ __device__ __forceinline__ int lds_byte(int r, int c) { const int st = (r >> 4) * 2 + (c >> 5), rr = r & 15, cc = c & 31, ob = rr * 64 + cc * 2; return st * 1024 + (ob ^ (((ob >> 9) & 1) << 5)); }
__host__ __device__ __forceinline__ void stage_rc(int b, int& R, int& C) { const int st = b / 1024, sb = b % 1024, swz = sb ^ (((sb >> 9) & 1) << 5); R = (st >> 1) * 16 + swz / 64; C = (st & 1) * 32 + (swz % 64) / 2; }
__host__ __device__ __forceinline__ int perm32(int rho) { const int n = rho >> 4, i = rho & 15; return 8 * (i >> 2) + 4 * n + (i & 3); }

struct Unit { int pm, pn; };
struct Gemm { const bf16_t* A; const bf16_t* Bt; int M, N, K; };

struct StaticOrder {
    int nM, nN, nwg, G, c;
    __host__ __device__ void init(int M, int N, int G_, int c_) { nM = M / BM; nN = N / BM; nwg = nM * nN; G = G_; c = c_; }
    __host__ __device__ bool next(int i, Unit& u) const {
        const long L = (long)i * G + c; if (L >= nwg) return false;
        int wgid = (int)L; { const int q = nwg / NXCD, r = nwg % NXCD, xcd = wgid % NXCD, off = wgid / NXCD; wgid = (xcd < r ? xcd * (q + 1) : r * (q + 1) + (xcd - r) * q) + off; }
        const int nig = WGM * nN, gid = wgid / nig, fm = gid * WGM, gsz = (nM - fm) < WGM ? (nM - fm) : WGM;
        u.pm = fm + ((wgid % nig) % gsz); u.pn = (wgid % nig) / gsz; return true;
    }
    __device__ __forceinline__ void a_ready(const Unit&) const {}
    __device__ __forceinline__ void done(const Unit&) const {}
};
__device__ __forceinline__ unsigned cvt_pk_bf16(float lo, float hi) { unsigned r; asm volatile("v_cvt_pk_bf16_f32 %0, %1, %2" : "=v"(r) : "v"(lo), "v"(hi)); return r; }

#define PG8_GAS __attribute__((address_space(1)))
typedef unsigned u32x2 __attribute__((ext_vector_type(2)));
constexpr int TD = 1024, TW = 1536;
constexpr float NORM_EPS = 1e-6f;
__device__ __forceinline__ float fast_sigmoid(float x) { return __builtin_amdgcn_rcpf(1.0f + __builtin_amdgcn_exp2f(-1.4426950408889634f * x)); }
__device__ __forceinline__ float row_inv_rms(const float* part, int row, int fq) {
    const f32x4 pv = *(const PG8_GAS f32x4*)(part + (size_t)row * 16 + 4 * fq);
    float s = (pv[0] + pv[1]) + (pv[2] + pv[3]);
    s += __shfl_xor(s, 16); s += __shfl_xor(s, 32);
    return __builtin_amdgcn_rsqf(s * (1.0f / TD) + NORM_EPS);
}
__device__ __forceinline__ void fill_inv_table(PG8_LAS float* invt, int ui, int pm, const float* part) {
    const int r = threadIdx.x >> 1, hf = threadIdx.x & 1;
    const float* pp = part + (size_t)(pm * BM + r) * 16 + 8 * hf;
    const f32x4 a = *(const PG8_GAS f32x4*)pp, b = *(const PG8_GAS f32x4*)(pp + 4);
    float s = ((a[0] + a[1]) + (a[2] + a[3])) + ((b[0] + b[1]) + (b[2] + b[3]));
    s += __shfl_xor(s, 1);
    if (hf == 0) invt[ui * BM + r] = __builtin_amdgcn_rsqf(s * (1.0f / TD) + NORM_EPS);
}
struct EpiInA {
    static constexpr bool PERM = true, AFTER_DRAIN = false;
    bf16_t* U; const PG8_LAS float* invt; mutable int cnt;
    __device__ __forceinline__ void operator()(const f32x4 (&acc)[2][2][4][2], const Unit& u, int wr, int wc, int fr, int fq) const {
        const int row0 = u.pm * BM + wr * 64 + fr, col0 = u.pn * BM + wc * 32 + 8 * fq;
#pragma unroll
        for (int ai = 0; ai < 2; ++ai)
#pragma unroll
            for (int m = 0; m < 4; ++m) {
                const int row = row0 + ai * HALF + m * 16;
                const float inv = invt[cnt * BM + wr * 64 + fr + ai * HALF + m * 16];
                bf16_t* rowp = U + (size_t)row * (2 * TW) + col0;
#pragma unroll
                for (int bj = 0; bj < 2; ++bj) {
                    const f32x4 v0 = acc[ai][bj][m][0] * inv, v1 = acc[ai][bj][m][1] * inv;
                    u32x4 w; w.x = cvt_pk_bf16(v0[0], v0[1]); w.y = cvt_pk_bf16(v0[2], v0[3]); w.z = cvt_pk_bf16(v1[0], v1[1]); w.w = cvt_pk_bf16(v1[2], v1[3]);
                    *(PG8_GAS u32x4*)(rowp + bj * HALF) = w;
                }
            }
        ++cnt;
    }
};
struct EpiInB {
    static constexpr bool PERM = false, AFTER_DRAIN = false;
    bf16_t* Y; const PG8_LAS float* invt; const float* cw; float* Ph; float* Qh; float* Ch; mutable int cnt;
    __device__ __forceinline__ void operator()(const f32x4 (&acc)[2][2][4][2], const Unit& u, int wr, int wc, int fr, int fq) const {
        const int row0 = u.pm * BM + wr * 64 + fr, ch0 = u.pn * 64 + wc * 16 + 4 * fq;
        const f32x4 w0 = *(const PG8_GAS f32x4*)(cw + ch0), w1 = *(const PG8_GAS f32x4*)(cw + TW + ch0), w2 = *(const PG8_GAS f32x4*)(cw + 2 * TW + ch0);
#pragma unroll
        for (int ai = 0; ai < 2; ++ai) {
            const int grp = u.pm * 4 + ai * 2 + wr;
            const bool seq_start = ((grp * 64) & 4095) == 0;
            f32x4 pprev = {0.f, 0.f, 0.f, 0.f};
#pragma unroll
            for (int m = 0; m < 4; ++m) {
                const int row = row0 + ai * HALF + m * 16;
                const float inv = invt[cnt * BM + wr * 64 + fr + ai * HALF + m * 16];
                const f32x4 bg = acc[ai][0][m][0] * inv, cgv = acc[ai][0][m][1] * inv, xv = acc[ai][1][m][0] * inv, gt = acc[ai][1][m][1] * inv;
                const f32x4 p = cgv * xv; f32x4 q, p1, p2;
#pragma unroll
                for (int e = 0; e < 4; ++e) { q[e] = bg[e] * gt[e] * fast_sigmoid(gt[e]);
                    p1[e] = __builtin_bit_cast(float, __builtin_amdgcn_update_dpp(0, __builtin_bit_cast(int, fr == 15 ? pprev[e] : p[e]), 0x121, 0xf, 0xf, false));
                    p2[e] = __builtin_bit_cast(float, __builtin_amdgcn_update_dpp(0, __builtin_bit_cast(int, fr >= 14 ? pprev[e] : p[e]), 0x122, 0xf, 0xf, false)); }
                const f32x4 cv = w0 * p2 + w1 * p1 + w2 * p, y = q * cv;
                u32x2 yw; yw.x = cvt_pk_bf16(y[0], y[1]); yw.y = cvt_pk_bf16(y[2], y[3]);
                *(PG8_GAS u32x2*)(Y + (size_t)row * TW + ch0) = yw;
                if (m == 0 && fr < 2 && !seq_start) { const size_t o = ((size_t)grp * 2 + fr) * TW + ch0; *(PG8_GAS f32x4*)(Qh + o) = q; *(PG8_GAS f32x4*)(Ch + o) = cv; }
                if (m == 3 && fr >= 14) { const size_t o = ((size_t)grp * 2 + (fr - 14)) * TW + ch0; *(PG8_GAS f32x4*)(Ph + o) = p; }
                pprev = p;
            }
        }
        ++cnt;
    }
};
__device__ __forceinline__ void convb_fixup(int pm, bf16_t* Y, const float* cw, const float* Ph, const float* Qh, const float* Ch) {
#pragma unroll 2
    for (int k = 0; k < (4 * 2 * (TW / 4)) / 512; ++k) {
        const int it = (int)threadIdx.x + 512 * k;
        const int c4 = it % (TW / 4), rr = (it / (TW / 4)) & 1, g = it / (2 * (TW / 4)), grp = pm * 4 + g, ch = 4 * c4;
        const bool skip = ((grp * 64) & 4095) == 0;
        const size_t o = ((size_t)grp * 2 + rr) * TW + ch, op = ((size_t)(skip ? grp : grp - 1) * 2) * TW + ch;
        const f32x4 q = *(const PG8_GAS f32x4*)(Qh + o); f32x4 cv = *(const PG8_GAS f32x4*)(Ch + o);
        const f32x4 w0 = *(const PG8_GAS f32x4*)(cw + ch), w1 = *(const PG8_GAS f32x4*)(cw + TW + ch);
        const f32x4 pa = *(const PG8_GAS f32x4*)(Ph + op), pb = *(const PG8_GAS f32x4*)(Ph + op + TW);
        if (rr == 0) cv += w0 * pa + w1 * pb; else cv += w0 * pb;
        const f32x4 y = q * cv;
        u32x2 yw; yw.x = cvt_pk_bf16(y[0], y[1]); yw.y = cvt_pk_bf16(y[2], y[3]);
        if (!skip) *(PG8_GAS u32x2*)(Y + ((size_t)grp * 64 + rr) * TW + ch) = yw;
    }
}
struct EpiOut {
    static constexpr bool PERM = true, AFTER_DRAIN = false;
    bf16_t* x16; float* part;
    __device__ __forceinline__ void operator()(const f32x4 (&acc)[2][2][4][2], const Unit& u, int wr, int wc, int fr, int fq) const {
        const int row0 = u.pm * BM + wr * 64 + fr, col0 = u.pn * BM + wc * 32 + 8 * fq;
#pragma unroll
        for (int ai = 0; ai < 2; ++ai)
#pragma unroll
            for (int m = 0; m < 4; ++m) {
                const int row = row0 + ai * HALF + m * 16;
                bf16_t* rowp = x16 + (size_t)row * TD + col0;
                float ss = 0.f;
#pragma unroll
                for (int bj = 0; bj < 2; ++bj) {
                    const u32x4 rv = *(const PG8_GAS u32x4*)(rowp + bj * HALF);
                    const f32x4 r0 = {__builtin_bit_cast(float, rv.x << 16), __builtin_bit_cast(float, rv.x & 0xffff0000u), __builtin_bit_cast(float, rv.y << 16), __builtin_bit_cast(float, rv.y & 0xffff0000u)};
                    const f32x4 r1 = {__builtin_bit_cast(float, rv.z << 16), __builtin_bit_cast(float, rv.z & 0xffff0000u), __builtin_bit_cast(float, rv.w << 16), __builtin_bit_cast(float, rv.w & 0xffff0000u)};
                    const f32x4 v0 = acc[ai][bj][m][0] + r0, v1 = acc[ai][bj][m][1] + r1;
                    u32x4 w; w.x = cvt_pk_bf16(v0[0], v0[1]); w.y = cvt_pk_bf16(v0[2], v0[3]); w.z = cvt_pk_bf16(v1[0], v1[1]); w.w = cvt_pk_bf16(v1[2], v1[3]);
                    *(PG8_GAS u32x4*)(rowp + bj * HALF) = w;
                    const unsigned ww[4] = {w.x, w.y, w.z, w.w};
#pragma unroll
                    for (int e = 0; e < 4; ++e) { const float a = __builtin_bit_cast(float, ww[e] << 16), b = __builtin_bit_cast(float, ww[e] & 0xffff0000u); ss += a * a + b * b; }
                }
                ss += __shfl_xor(ss, 16); ss += __shfl_xor(ss, 32);
                if (fq == 0) *(PG8_GAS float*)(part + (size_t)row * 16 + 4 * u.pn + wc) = ss;
            }
    }
};
template <class Epi, class Sched, bool ALIGN_EPI = false, bool SP2 = false>
__device__ __forceinline__ void gemm_phase(PG8_LAS unsigned char* lds, const Gemm g, const Sched& S, const Epi& E) {
    int tid_ = threadIdx.x; asm volatile("" : "+v"(tid_));
    const int tid = tid_, wid = __builtin_amdgcn_readfirstlane(tid >> 6), lane = tid & 63, wr = wid >> 2, wc = wid & 3, fr = lane & 15, fq = lane >> 4;
    const int K = g.K, nt = K / BK;
    unsigned voffA[2], voffB[2];
#pragma unroll
    for (int i = 0; i < 2; ++i) { int R, C; stage_rc(tid * 16 + i * 8192, R, C); const int Rb = Epi::PERM ? ((R & ~31) + perm32(R & 31)) : R;
        voffA[i] = (unsigned)(R * K + C) * 2u; voffB[i] = (unsigned)(Rb * K + C) * 2u; }
    const size_t kstep = (size_t)(BK * 2);
    const size_t hstep = (size_t)HALF * K * 2;
    const size_t tstep = 2 * hstep;
    const unsigned ldsw = (unsigned)wid * 1024u;
    const int aoff = lds_byte(wr * 64 + fr, fq * 8), boff = lds_byte(wc * 32 + fr, fq * 8);
#define PG8_SA(b, h) (((b) * 2 + (h)) * HTB)
#define PG8_SB(b, h) ((4 + (b) * 2 + (h)) * HTB)
#define PG8_STAGE(bufoff, gbase, voff) do { _Pragma("unroll") for (int _i = 0; _i < 2; ++_i) \
        __builtin_amdgcn_global_load_lds((const unsigned*)((const char*)(gbase) + (voff)[_i]), (PG8_LAS unsigned*)(lds + (bufoff) + ldsw + _i * 8192), 16, 0, 0); } while (0)
#define PG8_LDA(dst, b, h) do { _Pragma("unroll") for (int m = 0; m < 4; ++m) _Pragma("unroll") for (int k = 0; k < 2; ++k) dst[m][k] = *(const PG8_LAS bf16x8*)(lds + PG8_SA(b, h) + aoff + m * 2048 + k * 1024); } while (0)
#define PG8_LDB(dst, b, h) do { _Pragma("unroll") for (int n = 0; n < 2; ++n) _Pragma("unroll") for (int k = 0; k < 2; ++k) dst[n][k] = *(const PG8_LAS bf16x8*)(lds + PG8_SB(b, h) + boff + n * 2048 + k * 1024); } while (0)
#define PG8_MMA(ai, bj, At, Bt) do { __builtin_amdgcn_s_setprio(1); _Pragma("unroll") for (int m = 0; m < 4; ++m) _Pragma("unroll") for (int n = 0; n < 2; ++n) _Pragma("unroll") for (int k = 0; k < 2; ++k) \
        acc[ai][bj][m][n] = __builtin_amdgcn_mfma_f32_16x16x32_bf16(Bt[n][k], At[m][k], acc[ai][bj][m][n], 0, 0, 0); __builtin_amdgcn_s_setprio(0); } while (0)
#define PG8_WAIT_V(n) asm volatile("s_waitcnt vmcnt(" #n ")" ::: "memory")
#define PG8_WAIT_L(n) asm volatile("s_waitcnt lgkmcnt(" #n ")" ::: "memory")
#define PG8_BAR __builtin_amdgcn_s_barrier()
#define PG8_SCHED __builtin_amdgcn_sched_barrier(0)
    Unit cur, nxt; int ui = 0;
    if (!S.next(0, cur)) return;
    f32x4 acc[2][2][4][2];
#pragma unroll
    for (int a = 0; a < 2; ++a)
#pragma unroll
        for (int b = 0; b < 2; ++b)
#pragma unroll
            for (int m = 0; m < 4; ++m)
#pragma unroll
                for (int n = 0; n < 2; ++n) acc[a][b][m][n] = (f32x4){0.f, 0.f, 0.f, 0.f};
    bf16x8 At[4][2], B0[2][2], B1[2][2];
    const char* cA = (const char*)g.A + (size_t)cur.pm * tstep; const char* cB = (const char*)g.Bt + (size_t)cur.pn * tstep;
    S.a_ready(cur);
    if constexpr (SP2) {
        PG8_STAGE(PG8_SB(0, 0), cB, voffB); PG8_STAGE(PG8_SB(0, 1), cB + hstep, voffB); PG8_STAGE(PG8_SA(0, 0), cA, voffA); PG8_STAGE(PG8_SA(0, 1), cA + hstep, voffA);
        if (wr == 1) PG8_BAR;
        PG8_WAIT_V(2); PG8_BAR;
        PG8_STAGE(PG8_SB(1, 0), cB + kstep, voffB); PG8_STAGE(PG8_SA(1, 0), cA + kstep, voffA); PG8_STAGE(PG8_SB(1, 1), cB + hstep + kstep, voffB);
        PG8_WAIT_V(6); PG8_BAR;
    } else {
        PG8_STAGE(PG8_SB(0, 0), cB, voffB); PG8_STAGE(PG8_SA(0, 0), cA, voffA); PG8_STAGE(PG8_SB(0, 1), cB + hstep, voffB); PG8_STAGE(PG8_SA(0, 1), cA + hstep, voffA);
        if (wr == 1) PG8_BAR;
        PG8_WAIT_V(4); PG8_BAR;
        PG8_STAGE(PG8_SB(1, 0), cB + kstep, voffB); PG8_STAGE(PG8_SA(1, 0), cA + kstep, voffA); PG8_STAGE(PG8_SB(1, 1), cB + hstep + kstep, voffB);
        PG8_WAIT_V(6); PG8_BAR;
    }
    for (;;) {
        const bool has_next = S.next(ui + 1, nxt);
        const char* nA = has_next ? (const char*)g.A + (size_t)nxt.pm * tstep : cA; const char* nB = has_next ? (const char*)g.Bt + (size_t)nxt.pn * tstep : cB;
        for (int t = 0; t < nt; t += 2) {
            const bool last = (t == nt - 2);
            const char* a1 = cA + (size_t)(t + 1) * kstep;
            const char* a2 = last ? nA : cA + (size_t)(t + 2) * kstep; const char* b2 = last ? nB : cB + (size_t)(t + 2) * kstep;
            const char* a3 = a2 + kstep; const char* b3 = b2 + kstep;
            if (last && has_next) S.a_ready(nxt);
            if constexpr (SP2) {
            PG8_LDB(B0, 0, 0); PG8_LDB(B1, 0, 1); PG8_SCHED; PG8_LDA(At, 0, 0); PG8_STAGE(PG8_SA(1, 1), a1 + hstep, voffA);
            PG8_WAIT_V(8); PG8_WAIT_L(0); PG8_BAR; PG8_MMA(0, 0, At, B0); PG8_MMA(0, 1, At, B1); PG8_BAR; PG8_SCHED;
            PG8_LDA(At, 0, 1); PG8_STAGE(PG8_SB(0, 0), b2, voffB); PG8_STAGE(PG8_SB(0, 1), b2 + hstep, voffB); PG8_STAGE(PG8_SA(0, 0), a2, voffA);
            PG8_WAIT_V(8); PG8_WAIT_L(0); PG8_BAR; PG8_MMA(1, 0, At, B0); PG8_MMA(1, 1, At, B1); PG8_BAR; PG8_SCHED;
            PG8_LDB(B0, 1, 0); PG8_LDB(B1, 1, 1); PG8_SCHED; PG8_LDA(At, 1, 0); PG8_STAGE(PG8_SA(0, 1), a2 + hstep, voffA);
            PG8_WAIT_V(8); PG8_WAIT_L(0); PG8_BAR; PG8_MMA(0, 0, At, B0); PG8_MMA(0, 1, At, B1); PG8_BAR; PG8_SCHED;
            PG8_LDA(At, 1, 1); PG8_STAGE(PG8_SB(1, 0), b3, voffB); PG8_STAGE(PG8_SB(1, 1), b3 + hstep, voffB); PG8_STAGE(PG8_SA(1, 0), a3, voffA);
            PG8_WAIT_V(8); PG8_WAIT_L(0); PG8_BAR; PG8_MMA(1, 0, At, B0); PG8_MMA(1, 1, At, B1); PG8_BAR; PG8_SCHED;
            } else {
            PG8_LDB(B0, 0, 0); PG8_SCHED; PG8_LDA(At, 0, 0); PG8_STAGE(PG8_SA(1, 1), a1 + hstep, voffA);
            PG8_WAIT_L(8); PG8_BAR; PG8_WAIT_L(0); PG8_MMA(0, 0, At, B0); PG8_BAR; PG8_SCHED;
            PG8_LDB(B1, 0, 1); PG8_STAGE(PG8_SB(0, 0), b2, voffB);
            PG8_BAR; PG8_WAIT_L(0); PG8_MMA(0, 1, At, B1); PG8_BAR;
            PG8_LDA(At, 0, 1); PG8_STAGE(PG8_SA(0, 0), a2, voffA);
            PG8_BAR; PG8_WAIT_L(0); PG8_MMA(1, 0, At, B0); PG8_BAR; PG8_SCHED;
            PG8_STAGE(PG8_SB(0, 1), b2 + hstep, voffB);
            PG8_WAIT_V(6); PG8_BAR; PG8_MMA(1, 1, At, B1); PG8_BAR;
            PG8_LDB(B0, 1, 0); PG8_SCHED; PG8_LDA(At, 1, 0); PG8_STAGE(PG8_SA(0, 1), a2 + hstep, voffA);
            PG8_WAIT_L(8); PG8_BAR; PG8_WAIT_L(0); PG8_MMA(0, 0, At, B0); PG8_BAR; PG8_SCHED;
            PG8_LDB(B1, 1, 1); PG8_STAGE(PG8_SB(1, 0), b3, voffB);
            PG8_BAR; PG8_WAIT_L(0); PG8_MMA(0, 1, At, B1); PG8_BAR;
            PG8_LDA(At, 1, 1); PG8_STAGE(PG8_SA(1, 0), a3, voffA);
            PG8_BAR; PG8_WAIT_L(0); PG8_MMA(1, 0, At, B0); PG8_BAR; PG8_SCHED;
            PG8_STAGE(PG8_SB(1, 1), b3 + hstep, voffB);
            PG8_WAIT_V(6); PG8_BAR; PG8_MMA(1, 1, At, B1); PG8_BAR;
            }
        }
        if constexpr (ALIGN_EPI) { if (wr == 0) PG8_BAR; }
        if constexpr (!Epi::AFTER_DRAIN) { E(acc, cur, wr, wc, fr, fq); S.done(cur); }
        if (!has_next) break;
#pragma unroll
        for (int a = 0; a < 2; ++a)
#pragma unroll
            for (int b = 0; b < 2; ++b)
#pragma unroll
                for (int m = 0; m < 4; ++m)
#pragma unroll
                    for (int n = 0; n < 2; ++n) acc[a][b][m][n] = (f32x4){0.f, 0.f, 0.f, 0.f};
        cur = nxt; cA = nA; cB = nB; ++ui;
        if constexpr (ALIGN_EPI) { if (wr == 1) PG8_BAR; }
    }
    PG8_WAIT_V(0);
    if constexpr (!ALIGN_EPI) { if (wr == 0) PG8_BAR; }
    PG8_BAR;
    if constexpr (Epi::AFTER_DRAIN) { E.fused(acc, cur, wr, wc, fr, fq, lds, wid, lane); S.done(cur); }
#undef PG8_SA
#undef PG8_SB
#undef PG8_STAGE
#undef PG8_LDA
#undef PG8_LDB
#undef PG8_MMA
#undef PG8_WAIT_V
#undef PG8_WAIT_L
#undef PG8_BAR
#undef PG8_SCHED
}
}

namespace cg = cooperative_groups;
#define LAS __attribute__((address_space(3)))
#define GAS __attribute__((address_space(1)))
typedef unsigned short bf16;
typedef unsigned v4u __attribute__((ext_vector_type(4)));
typedef unsigned v2u __attribute__((ext_vector_type(2)));
typedef float f32x4 __attribute__((ext_vector_type(4)));
typedef short bf16x8 __attribute__((ext_vector_type(8)));
#define LDS_WAIT() asm volatile("s_waitcnt lgkmcnt(0)" ::: "memory")

constexpr int NWAVES = 8;
constexpr int NB = 8, SEQ = 4096, T = NB * SEQ, D = 1024, W = 1536, NH = 12;
constexpr int CHUNK = 256, NCHUNK = SEQ / CHUNK;
constexpr float EPS = 1e-6f;
constexpr size_t MiB = 1u << 20;
constexpr size_t WS_X16 = 0;
constexpr size_t WS_U = 64 * MiB;
constexpr size_t WS_Y = 256 * MiB;
constexpr size_t WS_WINA = 352 * MiB;
constexpr size_t WS_WOUTA = 364 * MiB;
constexpr size_t WS_WINB = 370 * MiB;
constexpr size_t WS_WOUTB = 394 * MiB;
constexpr size_t WS_GW = 400 * MiB;
constexpr size_t WS_PART = 402 * MiB;
constexpr size_t WS_SP = 412 * MiB;
constexpr size_t WS_CTL = 413 * MiB;
constexpr size_t WS_GRAN = WS_CTL + 16384;
constexpr size_t CTL_BYTES = 16384 + (size_t)8 * 16 * 1536 * 8;
constexpr size_t WS_PH = 416 * MiB, WS_QH = 424 * MiB, WS_CHH = 432 * MiB;
constexpr size_t WS_END = 440 * MiB;
constexpr int LDS_BYTES = 147456;
constexpr int MISC_OFF = LDS_BYTES - 256;
constexpr int XP = 272;

__device__ __forceinline__ float bf2f(unsigned short b) { return __builtin_bit_cast(float, (unsigned)b << 16); }
__device__ __forceinline__ float bflo(unsigned u) { return __builtin_bit_cast(float, u << 16); }
__device__ __forceinline__ float bfhi(unsigned u) { return __builtin_bit_cast(float, u & 0xffff0000u); }
__device__ __forceinline__ unsigned pk2(float lo, float hi) { return pg8::cvt_pk_bf16(lo, hi); }
constexpr float L2E = 1.4426950408889634f;
__device__ __forceinline__ float sigm(float x) { return __builtin_amdgcn_rcpf(1.0f + __builtin_amdgcn_exp2f(-L2E * x)); }
__device__ __forceinline__ float wave_sum(float v) {
#pragma unroll
    for (int o = 1; o < 64; o <<= 1) v += __shfl_xor(v, o);
    return v;
}

#define XB_TMO      128
#define XB_XCNT(j)  (256  + 64 * (j))
#define XB_XSUB(j)  (1280 + 64 * (j))
#define XB_XGEN(j)  (2304 + 64 * (j))
#define XB_TOP      3328
#define XB_TOPGEN   3392
#define XCD_BAR_WORDS 3456
#define XB_SPIN_CAP (1u << 18)

__device__ __forceinline__ unsigned xb_ld(unsigned* p)              { return __hip_atomic_load(p, __ATOMIC_RELAXED, __HIP_MEMORY_SCOPE_AGENT); }
__device__ __forceinline__ unsigned xb_add(unsigned* p, unsigned v) { return __hip_atomic_fetch_add(p, v, __ATOMIC_RELAXED, __HIP_MEMORY_SCOPE_AGENT); }
__device__ __forceinline__ unsigned xb_xcc_id() { return (unsigned)__builtin_amdgcn_s_getreg((3 << 11) | 20) & 0xFu; }
#define XB_SPIN(cond, bar) do { unsigned _sp = 0; while (cond) { __builtin_amdgcn_s_sleep(1); \
    if ((++_sp & 255u) == 0u) { if (xb_ld(&(bar)[XB_TMO])) break; if (_sp > XB_SPIN_CAP) { atomicAdd(&(bar)[XB_TMO], 1u); break; } } } } while (0)

struct XcdBarrier {
    unsigned* bar; unsigned x;
    volatile LAS unsigned* st;
};

__device__ __forceinline__ XcdBarrier xcd_barrier_post(unsigned* bar, volatile LAS unsigned* st) {
    XcdBarrier b; b.bar = bar; b.x = xb_xcc_id(); b.st = st;
    if (threadIdx.x == 0) (void)xb_add(&bar[XB_XCNT(b.x)], 1u);
    return b;
}
__device__ __forceinline__ void xcd_barrier_complete(unsigned* bar, unsigned x, unsigned& nloc, unsigned& nx) {
    const unsigned G = gridDim.x * gridDim.y * gridDim.z;
    unsigned sum, cnt, mine, sp = 0u;
    for (;;) {
        sum = 0u; cnt = 0u; mine = 0u;
#pragma unroll
        for (unsigned j = 0; j < 16; ++j) { const unsigned c = xb_ld(&bar[XB_XCNT(j)]); sum += c; cnt += (c > 0u) ? 1u : 0u; mine = (j == x) ? c : mine; }
        if (sum == G) break;
        __builtin_amdgcn_s_sleep(1);
        if ((++sp & 255u) == 0u) { if (xb_ld(&bar[XB_TMO])) break; if (sp > XB_SPIN_CAP) { atomicAdd(&bar[XB_TMO], 1u); break; } }
    }
    nloc = mine > 0u ? mine : 1u; nx = cnt > 0u ? cnt : 1u;
}

__device__ __forceinline__ void xcd_barrier(const XcdBarrier& b) {
    asm volatile("s_waitcnt vmcnt(0)" ::: "memory");
    __syncthreads();
    if (threadIdx.x == 0) {
        unsigned* bar = b.bar;
        __builtin_amdgcn_s_waitcnt(0);
        unsigned nloc = b.st[0], nx = b.st[1];
        if (nloc == 0u) { xcd_barrier_complete(bar, b.x, nloc, nx); b.st[0] = nloc; b.st[1] = nx; }
        const unsigned old = xb_add(&bar[XB_XSUB(b.x)], 1u);
        const unsigned gen = old / nloc;
        if (old + 1u == (gen + 1u) * nloc) {
            __builtin_amdgcn_fence(__ATOMIC_RELEASE, "agent");
            asm volatile("s_waitcnt vmcnt(0)" ::: "memory");
            const unsigned og = xb_add(&bar[XB_TOP], 1u);
            const unsigned tg = og / nx;
            if (og + 1u == (tg + 1u) * nx) xb_add(&bar[XB_TOPGEN], 1u);
            else XB_SPIN(xb_ld(&bar[XB_TOPGEN]) == tg, bar);
            __builtin_amdgcn_fence(__ATOMIC_ACQUIRE, "agent");
            xb_add(&bar[XB_XGEN(b.x)], 1u);
            asm volatile("s_waitcnt vmcnt(0)" ::: "memory");
        } else {
            XB_SPIN(xb_ld(&bar[XB_XGEN(b.x)]) == gen, bar);
            __builtin_amdgcn_fence(__ATOMIC_ACQUIRE, "agent");
            asm volatile("s_waitcnt vmcnt(0)" ::: "memory");
        }
    }
    __syncthreads();
}

template <int MAP>
__device__ __forceinline__ void transpose_item(const float* Wsrc, int K, int N, const float* scale, bf16* WT, LAS float* scr, int item, int lane) {
    const int nblk = N / 32, kb = item / nblk, nb = item % nblk, k0 = 64 * kb, n0 = 32 * nb;
    float tv[32];
#pragma unroll
    for (int i = 0; i < 32; ++i) { const int kk = 2 * i + (lane >> 5);
        tv[i] = __builtin_nontemporal_load((const GAS float*)(Wsrc + (size_t)(k0 + kk) * N + n0 + (lane & 31))); }
#pragma unroll
    for (int i = 0; i < 32; ++i) { const int kk = 2 * i + (lane >> 5);
        float v = tv[i];
        if (scale) v *= *(const GAS float*)(scale + k0 + kk);
        scr[kk * 33 + (lane & 31)] = v; }
    LDS_WAIT(); asm volatile("" ::: "memory");
    const int c = lane & 7;
#pragma unroll
    for (int jj = 0; jj < 4; ++jj) { const int n = (lane >> 3) + 8 * jj; const LAS float* s = scr + (8 * c) * 33 + n;
        v4u o; o.x = pk2(s[0 * 33], s[1 * 33]); o.y = pk2(s[2 * 33], s[3 * 33]); o.z = pk2(s[4 * 33], s[5 * 33]); o.w = pk2(s[6 * 33], s[7 * 33]);
        int dn = n0 + n;
        if (MAP == 1) { const int type = dn / W, chn = dn % W, pn = chn >> 6, r64 = chn & 63, wc = r64 >> 4, low = r64 & 15;
            dn = 256 * pn + 128 * (type >> 1) + 32 * wc + 16 * (type & 1) + low; }
        *(GAS v4u*)(WT + (size_t)dn * K + k0 + 8 * c) = o; }
    LDS_WAIT(); asm volatile("" ::: "memory");
}

struct Args { const float* in[13]; float* out; unsigned char* ws; int ph_lo, ph_hi; };

__device__ __forceinline__ void prologue(const Args& a, LAS unsigned char* lds, int gw, int NGW, int lane, int wave) {
    unsigned char* ws = a.ws;
    LAS float* scr = (LAS float*)(lds + wave * 16384);
    constexpr int IA_IN = 16 * 96, IA_OUT = 24 * 32, IB_IN = 16 * 192, IB_OUT = 24 * 32, IG = 12 * 16, IPJ = IA_IN + IA_OUT + IB_IN + IB_OUT + IG;
    for (int it = gw; it < 2 * IPJ; it += NGW) {
        const int j = it / IPJ; int r = it % IPJ;
        if (r < IA_IN) { transpose_item<0>(a.in[2] + (size_t)j * D * 2 * W, D, 2 * W, a.in[1] + (size_t)(2 * j) * D, (bf16*)(ws + WS_WINA) + (size_t)j * 2 * W * D, scr, r, lane); continue; } r -= IA_IN;
        if (r < IA_OUT) { transpose_item<0>(a.in[8] + (size_t)j * W * D, W, D, nullptr, (bf16*)(ws + WS_WOUTA) + (size_t)j * D * W, scr, r, lane); continue; } r -= IA_OUT;
        if (r < IB_IN) { transpose_item<1>(a.in[9] + (size_t)j * D * 4 * W, D, 4 * W, a.in[1] + (size_t)(2 * j + 1) * D, (bf16*)(ws + WS_WINB) + (size_t)j * 4 * W * D, scr, r, lane); continue; } r -= IB_IN;
        if (r < IB_OUT) { transpose_item<0>(a.in[11] + (size_t)j * W * D, W, D, nullptr, (bf16*)(ws + WS_WOUTB) + (size_t)j * D * W, scr, r, lane); continue; } r -= IB_OUT;
        { const int h = r / 16, ri = r % 16;
          transpose_item<0>(a.in[5] + (size_t)(j * NH + h) * 128 * 256, 128, 256, nullptr, (bf16*)(ws + WS_GW) + (size_t)(j * NH + h) * 256 * 128, scr, ri, lane); }
    }
    const float* x = a.in[0]; bf16* x16 = (bf16*)(ws + WS_X16); float* part = (float*)(ws + WS_PART);
    for (int m = gw; m < T; m += NGW) {
        const GAS f32x4* xr = (const GAS f32x4*)(x + (size_t)m * D) + lane;
        f32x4 v[4]; float s = 0.f;
#pragma unroll
        for (int jj = 0; jj < 4; ++jj) { v[jj] = __builtin_nontemporal_load(xr + 64 * jj); s += (v[jj][0] * v[jj][0] + v[jj][1] * v[jj][1]) + (v[jj][2] * v[jj][2] + v[jj][3] * v[jj][3]); }
        s = wave_sum(s);
        GAS v2u* o8 = (GAS v2u*)(x16 + (size_t)m * D) + lane;
#pragma unroll
        for (int jj = 0; jj < 4; ++jj) { v2u o; o.x = pk2(v[jj][0], v[jj][1]); o.y = pk2(v[jj][2], v[jj][3]); o8[64 * jj] = o; }
        if (lane < 16) *(GAS float*)(part + (size_t)m * 16 + lane) = (lane == 0) ? s : 0.f;
    }
    for (int i = gw * 64 + lane; i < 2 * W; i += NGW * 64) *(GAS float*)((float*)(ws + WS_SP) + i) = log1pf(expf(-a.in[7][i]));
}

__device__ __forceinline__ void scan_single(LAS unsigned char* lds, const bf16* U, bf16* Y, const bf16* GWl, const float* gate_b, const float* conv_w, const float* conv_b,
                                            const float* sp, unsigned long long* gran, unsigned epoch) {
    int tid_ = threadIdx.x; asm volatile("" : "+v"(tid_));
    const int tid = tid_, lane = tid & 63, w = __builtin_amdgcn_readfirstlane(tid >> 6), j = lane & 15, q = lane >> 4;
    LAS unsigned char* xcs = lds; LAS unsigned char* gts = lds + 256 * XP;
    const int cgp = tid & 15, tg = tid >> 4;
    v4u xr[11];
#define SC_ISSUE(it_) do { const int bh_ = (it_) % (NB * NH), c_ = (it_) / (NB * NH), h_ = bh_ % NH, b_ = bh_ / NH; const size_t g0_ = (size_t)b_ * SEQ + (size_t)CHUNK * c_; const int ch_ = 128 * h_ + 8 * cgp, tl0_ = 8 * tg; \
        _Pragma("unroll") for (int r = 0; r < 11; ++r) { const int tl = tl0_ - 3 + r; if (CHUNK * c_ + tl >= 0) xr[r] = __builtin_nontemporal_load((const GAS v4u*)(U + (g0_ + tl) * (size_t)(2 * W) + W + ch_)); else xr[r] = (v4u){0u, 0u, 0u, 0u}; } \
        } while (0)
    if ((int)blockIdx.x < NB * NCHUNK * NH) SC_ISSUE((int)blockIdx.x);
    for (int item = blockIdx.x; item < NB * NCHUNK * NH; item += gridDim.x) {
        const int bh = item % (NB * NH), c = item / (NB * NH), h = bh % NH, b = bh / NH;
        const size_t grow0 = (size_t)b * SEQ + (size_t)CHUNK * c;
        GAS unsigned long long* gI = (GAS unsigned long long*)gran;
        const int chl = 128 * h + 16 * w + j;
        unsigned long long xi_pre = 0ull;
        if (c > 0) xi_pre = __hip_atomic_load(gI + ((size_t)b * NCHUNK + (c - 1)) * W + chl, __ATOMIC_RELAXED, __HIP_MEMORY_SCOPE_AGENT);
        {
            const int tl0 = 8 * tg, ch = 128 * h + 8 * cgp;
            v4u gr[8];
#pragma unroll
            for (int t = 0; t < 8; ++t) gr[t] = __builtin_nontemporal_load((const GAS v4u*)(U + (grow0 + tl0 + t) * (size_t)(2 * W) + ch));
            f32x4 wk[4][2], bs[2];
#pragma unroll
            for (int k = 0; k < 4; ++k) { wk[k][0] = *(const GAS f32x4*)(conv_w + (size_t)k * W + ch); wk[k][1] = *(const GAS f32x4*)(conv_w + (size_t)k * W + ch + 4); }
            bs[0] = *(const GAS f32x4*)(conv_b + ch); bs[1] = *(const GAS f32x4*)(conv_b + ch + 4);
#pragma unroll
            for (int t = 0; t < 8; ++t) {
                f32x4 o0 = bs[0], o1 = bs[1];
#pragma unroll
                for (int k = 0; k < 4; ++k) { const v4u xv = xr[t + k];
                    o0 += wk[k][0] * (f32x4){bflo(xv.x), bfhi(xv.x), bflo(xv.y), bfhi(xv.y)};
                    o1 += wk[k][1] * (f32x4){bflo(xv.z), bfhi(xv.z), bflo(xv.w), bfhi(xv.w)}; }
                const int tl = tl0 + t, R = 16 * ((tl >> 2) & 15) + 4 * (tl >> 6) + (tl & 3);
                v4u o; o.x = pk2(o0[0], o0[1]); o.y = pk2(o0[2], o0[3]); o.z = pk2(o1[0], o1[1]); o.w = pk2(o1[2], o1[3]);
                *(LAS v4u*)(xcs + R * XP + 16 * cgp) = o;
                *(LAS v4u*)(gts + R * XP + 16 * cgp) = gr[t];
            }
        }
        bf16x8 br[4], bi[4];
        { const bf16* gwr = GWl + ((size_t)(h * 256 + 16 * w + j) * 128 + 8 * q); const bf16* gwi = gwr + 128 * 128;
#pragma unroll
          for (int kk = 0; kk < 4; ++kk) { br[kk] = *(const GAS bf16x8*)(gwr + 32 * kk); bi[kk] = *(const GAS bf16x8*)(gwi + 32 * kk); } }
        const float gbr = *(const GAS float*)(gate_b + h * 256 + 16 * w + j), gbi = *(const GAS float*)(gate_b + h * 256 + 128 + 16 * w + j);
        const float c8 = -8.0f * L2E * *(const GAS float*)(sp + chl);
        const float gbrL = -L2E * gbr, gbiL = -L2E * gbi;
        __syncthreads();
        const LAS unsigned char* xel = xcs + (4 * q) * XP + 2 * (16 * w + j);
        LAS unsigned char* gel = gts + (4 * q) * XP + 2 * (16 * w + j);
        unsigned ps[16][2]; float Pq = 1.f, hl = 0.f; float pprev = 0.f;
        bf16x8 Af[2][4]; f32x4 accR[2], accI[2]; unsigned short xv_[2][4], gv_[2][4];
#define SC_LOAD_A(buf, mm) do { const LAS unsigned char* arow_ = xcs + (16 * (mm) + j) * XP + 16 * q; _Pragma("unroll") for (int kk = 0; kk < 4; ++kk) Af[buf][kk] = *(const LAS bf16x8*)(arow_ + 64 * kk); } while (0)
#define SC_LOAD_XG(buf, mm) do { _Pragma("unroll") for (int i = 0; i < 4; ++i) { xv_[buf][i] = *(const LAS unsigned short*)(xel + (16 * (mm) + i) * XP); gv_[buf][i] = *(const LAS unsigned short*)(gel + (16 * (mm) + i) * XP); } } while (0)
#define SC_MFMA(buf) do { accR[buf] = (f32x4){0.f, 0.f, 0.f, 0.f}; accI[buf] = (f32x4){0.f, 0.f, 0.f, 0.f}; _Pragma("unroll") for (int kk = 0; kk < 4; ++kk) { \
            accR[buf] = __builtin_amdgcn_mfma_f32_16x16x32_bf16(Af[buf][kk], br[kk], accR[buf], 0, 0, 0); accI[buf] = __builtin_amdgcn_mfma_f32_16x16x32_bf16(Af[buf][kk], bi[kk], accI[buf], 0, 0, 0); } } while (0)
        SC_LOAD_A(0, 0); SC_LOAD_XG(0, 0); SC_LOAD_A(1, 1); SC_MFMA(0);
#pragma unroll
        for (int m = 0; m < 16; ++m) {
            const int cur = m & 1, nxt = cur ^ 1;
            if (m + 1 < 16) { SC_MFMA(nxt); SC_LOAD_XG(nxt, m + 1); }
            if (m + 2 < 16) SC_LOAD_A(cur, m + 2);
#pragma unroll
            for (int i = 0; i < 4; ++i) {
                const float xcv = bf2f(xv_[cur][i]);
                const float g = bf2f(gv_[cur][i]);
                const float r = __builtin_amdgcn_rcpf(1.0f + __builtin_amdgcn_exp2f(__builtin_fmaf(accR[cur][i], -L2E, gbrL)));
                const float ig = __builtin_amdgcn_rcpf(1.0f + __builtin_amdgcn_exp2f(__builtin_fmaf(accI[cur][i], -L2E, gbiL)));
                const float av = __builtin_amdgcn_exp2f(c8 * r);
                const float mult = __builtin_amdgcn_sqrtf(__builtin_fmaf(-av, av, 1.0f));
                const float bt = mult * (ig * xcv);
                const float sg = g * __builtin_amdgcn_rcpf(1.0f + __builtin_amdgcn_exp2f(-L2E * g));
                hl = av * hl + bt; Pq *= av;
                *(LAS unsigned short*)(gel + (16 * m + i) * XP) = (unsigned short)(pk2(hl * sg, 0.f) & 0xffffu);
                { const float pv = Pq * sg; if (i & 1) ps[m][i >> 1] = pk2(pprev, pv); else pprev = pv; }
            }
        }
#undef SC_LOAD_A
#undef SC_LOAD_XG
#undef SC_MFMA
        if (item + (int)gridDim.x < NB * NCHUNK * NH) SC_ISSUE(item + (int)gridDim.x);
        const float A0 = __shfl(Pq, j), B0 = __shfl(hl, j), A1 = __shfl(Pq, 16 + j), B1 = __shfl(hl, 16 + j), A2 = __shfl(Pq, 32 + j), B2 = __shfl(hl, 32 + j), A3 = __shfl(Pq, 48 + j), B3 = __shfl(hl, 48 + j);
        const float E2A = A1 * A0, E2B = A1 * B0 + B1, E3A = A2 * E2A, E3B = A2 * E2B + B2, TA = A3 * E3A, TB = A3 * E3B + B3;
        const float EA = q == 0 ? 1.f : (q == 1 ? A0 : (q == 2 ? E2A : E3A)), EB = q == 0 ? 0.f : (q == 1 ? B0 : (q == 2 ? E2B : E3B));
        float Hin = 0.f;
        if (c > 0) {
            GAS unsigned long long* gp = (GAS unsigned long long*)gran + ((size_t)b * NCHUNK + (c - 1)) * W + chl;
            unsigned long long x = xi_pre; unsigned spins = 0;
            for (;;) { if (spins) x = __hip_atomic_load(gp, __ATOMIC_RELAXED, __HIP_MEMORY_SCOPE_AGENT);
                const bool ok = (unsigned)(x >> 32) == epoch;
                if (__all(ok)) break;
                __builtin_amdgcn_s_sleep(1);
                if (++spins > (1u << 16)) break; }
            Hin = __builtin_bit_cast(float, (unsigned)x);
        }
        if (c < NCHUNK - 1 && q == 0) {
            const float Hout = TB + TA * Hin;
            __hip_atomic_store((GAS unsigned long long*)gran + ((size_t)b * NCHUNK + c) * W + chl, ((unsigned long long)epoch << 32) | (unsigned long long)__builtin_bit_cast(unsigned, Hout), __ATOMIC_RELAXED, __HIP_MEMORY_SCOPE_AGENT);
        }
        const float Hq = EB + EA * Hin;
#pragma unroll
        for (int m = 0; m < 16; ++m)
#pragma unroll
            for (int i = 0; i < 4; ++i)
            { LAS unsigned short* yp = (LAS unsigned short*)(gel + (16 * m + i) * XP);
                *yp = (unsigned short)(pk2(__builtin_fmaf((i & 1) ? bfhi(ps[m][i >> 1]) : bflo(ps[m][i >> 1]), Hq, bf2f(*yp)), 0.f) & 0xffffu); }
        __syncthreads();
        {   const int ch = 128 * h + 8 * cgp, tl0 = 8 * tg;
#pragma unroll
            for (int t = 0; t < 8; ++t) { const int tl = tl0 + t, R = 16 * ((tl >> 2) & 15) + 4 * (tl >> 6) + (tl & 3);
                *(GAS v4u*)(Y + (grow0 + tl) * (size_t)W + ch) = *(const LAS v4u*)(gts + R * XP + 16 * cgp); } }
        __syncthreads();
    }
}

__device__ __forceinline__ void final_phase(const bf16* x16, float* xo, const float* part, const float* fg, int gw, int NGW, int lane) {
    f32x4 g[4];
#pragma unroll
    for (int jj = 0; jj < 4; ++jj) g[jj] = *((const GAS f32x4*)fg + lane + 64 * jj);
    for (int m = gw; m < T; m += NGW) {
        float s = (lane < 16) ? *(const GAS float*)(part + (size_t)m * 16 + lane) : 0.f;
        s = wave_sum(s);
        const float inv = __builtin_amdgcn_rsqf(s * (1.0f / D) + EPS);
        const GAS v2u* xi = (const GAS v2u*)(x16 + (size_t)m * D) + lane;
        GAS f32x4* xr = (GAS f32x4*)(xo + (size_t)m * D) + lane;
#pragma unroll
        for (int jj = 0; jj < 4; ++jj) { const v2u u = __builtin_nontemporal_load(xi + 64 * jj); const f32x4 v = {bflo(u.x), bfhi(u.x), bflo(u.y), bfhi(u.y)}; __builtin_nontemporal_store(v * inv * g[jj], xr + 64 * jj); }
    }
}

constexpr int N_PHASES = 16;
__global__ void __launch_bounds__(NWAVES * 64, 2) trunk_fwd(Args args) {
    extern __shared__ __attribute__((aligned(16))) unsigned char lds_raw[];
    LAS unsigned char* lds = (LAS unsigned char*)lds_raw;
    cg::grid_group grid = cg::this_grid();
    const int tid = threadIdx.x, lane = tid & 63, wave = __builtin_amdgcn_readfirstlane(tid >> 6);
    const int G = gridDim.x, gw = blockIdx.x * NWAVES + wave, NGW = G * NWAVES;
    const int lo = args.ph_lo, hi = args.ph_hi;
    unsigned char* ws = args.ws;
    bf16* X16 = (bf16*)(ws + WS_X16); bf16* U = (bf16*)(ws + WS_U); bf16* Y = (bf16*)(ws + WS_Y);
    float* part = (float*)(ws + WS_PART);
#define IN(k) (lo <= (k) && (k) < hi)
    if (tid < 2) ((volatile LAS unsigned*)(lds + MISC_OFF))[tid] = 0u;
    __syncthreads();
    XcdBarrier bar = xcd_barrier_post((unsigned*)(ws + WS_CTL), (volatile LAS unsigned*)(lds + MISC_OFF));
#define SEAM(k) do { if (IN(k) && IN((k) + 1)) { xcd_barrier(bar); } } while (0)
    if (args.ph_hi > 1000) grid.sync();
    if (IN(0)) { prologue(args, lds, gw, NGW, lane, wave); }
    SEAM(0);
    for (int l = 0; l < 4; ++l) {
        const int jl = l >> 1, base = 1 + 7 * jl + ((l & 1) ? 4 : 0);
        if (!(l & 1)) {
            if (IN(base)) {
                pg8::Gemm g{X16, (const bf16*)(ws + WS_WINA) + (size_t)jl * 2 * W * D, T, 2 * W, D}; pg8::StaticOrder S; S.init(T, 2 * W, G, (int)blockIdx.x);
                LAS float* invt = (LAS float*)(lds + 131072);
                { pg8::Unit fu; for (int ui = 0; S.next(ui, fu); ++ui) pg8::fill_inv_table(invt, ui, fu.pm, part); }
                __syncthreads();
                pg8::EpiInA E{U, invt, 0};
                pg8::gemm_phase<pg8::EpiInA, pg8::StaticOrder, true, true>(lds, g, S, E);
            }
            SEAM(base);
            const bf16* GWl = (const bf16*)(ws + WS_GW) + (size_t)jl * NH * 256 * 128;
            const float* gate_b = args.in[6] + (size_t)jl * NH * 256; const float* cw = args.in[3] + (size_t)jl * 4 * W; const float* cb = args.in[4] + (size_t)jl * W;
            const float* sp = (const float*)(ws + WS_SP) + (size_t)jl * W;
            if (IN(base + 2)) scan_single(lds, U, Y, GWl, gate_b, cw, cb, sp, (unsigned long long*)(ws + WS_GRAN), (unsigned)(jl + 1));
            SEAM(base + 2);
        } else {
            if (IN(base)) {
                pg8::Gemm g{X16, (const bf16*)(ws + WS_WINB) + (size_t)jl * 4 * W * D, T, 4 * W, D}; pg8::StaticOrder S; S.init(T, 4 * W, G, (int)blockIdx.x);
                LAS float* invt = (LAS float*)(lds + 131072);
                { pg8::Unit fu; for (int ui = 0; S.next(ui, fu); ++ui) pg8::fill_inv_table(invt, ui, fu.pm, part); }
                __syncthreads();
                pg8::EpiInB E{Y, invt, args.in[10] + (size_t)jl * 3 * W, (float*)(ws + WS_PH), (float*)(ws + WS_QH), (float*)(ws + WS_CHH), 0};
                pg8::gemm_phase<pg8::EpiInB, pg8::StaticOrder, true, true>(lds, g, S, E);
            }
            SEAM(base);
        }
        const int po = base + ((l & 1) ? 2 : 3);
        if (IN(po)) {
            const bf16* wo = (l & 1) ? (const bf16*)(ws + WS_WOUTB) + (size_t)jl * D * W : (const bf16*)(ws + WS_WOUTA) + (size_t)jl * D * W;
            pg8::Gemm g{Y, wo, T, D, W}; pg8::StaticOrder S; S.init(T, D, G, (int)blockIdx.x);
            if (l & 1) { pg8::Unit fu; for (int ui = 0; S.next(ui, fu); ++ui) pg8::convb_fixup(fu.pm, Y, args.in[10] + (size_t)jl * 3 * W, (const float*)(ws + WS_PH), (const float*)(ws + WS_QH), (const float*)(ws + WS_CHH));
                asm volatile("s_waitcnt vmcnt(0)" ::: "memory"); __syncthreads(); }
            pg8::EpiOut E{X16, part};
            pg8::gemm_phase<pg8::EpiOut, pg8::StaticOrder, true, true>(lds, g, S, E);
        }
        SEAM(po);
    }
    if (IN(15)) final_phase(X16, args.out, part, args.in[12], gw, NGW, lane);
#undef IN
#undef SEAM
}

extern "C" void kernel_launch(void* const* d_in, const int* in_sizes, int n_in, void* d_out, int out_size, void* d_ws, size_t ws_size, hipStream_t stream) {
    static int grid = 0;
    if (grid == 0) {
        if (n_in != 13 || in_sizes[0] != T * D || out_size != T * D || ws_size < WS_END) { fprintf(stderr, "kernel_launch: unexpected shapes (n_in %d, in0 %d, out %d, ws %zu); nothing launched\n", n_in, n_in > 0 ? in_sizes[0] : -1, out_size, ws_size); grid = -1; return; }
        int dev = 0, cus = 0, per_cu = 0;
        if (hipGetDevice(&dev) != hipSuccess || hipDeviceGetAttribute(&cus, hipDeviceAttributeMultiprocessorCount, dev) != hipSuccess) { grid = -1; return; }
        if (hipFuncSetAttribute((const void*)trunk_fwd, hipFuncAttributeMaxDynamicSharedMemorySize, LDS_BYTES) != hipSuccess) { fprintf(stderr, "kernel_launch: hipFuncSetAttribute failed\n"); grid = -1; return; }
        if (hipOccupancyMaxActiveBlocksPerMultiprocessor(&per_cu, (const void*)trunk_fwd, NWAVES * 64, LDS_BYTES) != hipSuccess || per_cu < 1) { fprintf(stderr, "kernel_launch: occupancy query gave %d\n", per_cu); per_cu = 1; }
        (void)hipGetLastError();
        grid = cus * 1;
    }
    if (grid < 0) return;
    if (hipMemsetAsync((char*)d_ws + WS_CTL, 0, CTL_BYTES, stream) != hipSuccess) { fprintf(stderr, "kernel_launch: memset failed\n"); return; }
    Args a{};
    for (int i = 0; i < 13; ++i) a.in[i] = (const float*)d_in[i];
    a.out = (float*)d_out; a.ws = (unsigned char*)d_ws;
    a.ph_lo = 0; a.ph_hi = N_PHASES;
    void* kargs[] = {&a};
    const hipError_t e = hipLaunchCooperativeKernel((const void*)trunk_fwd, dim3(grid), dim3(NWAVES * 64), kargs, LDS_BYTES, stream);
    if (e != hipSuccess) fprintf(stderr, "kernel_launch: cooperative launch failed: %s (grid %d)\n", hipGetErrorString(e), grid);
}
```

```cpp
#include <hip/hip_runtime.h>
#include <hip/hip_cooperative_groups.h>
#include <cstdio>
#include <cstdint>
namespace pg8 {
#define PG8_LAS __attribute__((address_space(3)))
typedef unsigned short bf16_t;
typedef short bf16x8 __attribute__((ext_vector_type(8)));
typedef float f32x4 __attribute__((ext_vector_type(4)));
typedef unsigned u32x4 __attribute__((ext_vector_type(4)));
constexpr int BM = 256, BK = 64, HALF = 128, HTB = HALF * BK * 2  , STAGE_BYTES = 8 * HTB, NXCD = 8, WGM = 8;

__host__ __device__ __forceinline__ int lds_byte(int r, int c) { const int st = (r >> 4) * 2 + (c >> 5), rr = r & 15, cc = c & 31, ob = rr * 64 + cc * 2; return st * 1024 + (ob ^ (((ob >> 9) & 1) << 5)); }
__host__ __device__ __forceinline__ void stage_rc(int b, int& R, int& C) { const int st = b / 1024, sb = b % 1024, swz = sb ^ (((sb >> 9) & 1) << 5); R = (st >> 1) * 16 + swz / 64; C = (st & 1) * 32 + (swz % 64) / 2; }
__host__ __device__ __forceinline__ int perm32(int rho) { const int n = rho >> 4, i = rho & 15; return 8 * (i >> 2) + 4 * n + (i & 3); }

struct Unit { int pm, pn; };
struct Gemm { const bf16_t* A; const bf16_t* Bt; int M, N, K; };

struct StaticOrder {
    int nM, nN, nwg, G, c;
    __host__ __device__ void init(int M, int N, int G_, int c_) { nM = M / BM; nN = N / BM; nwg = nM * nN; G = G_; c = c_; }
    __host__ __device__ bool next(int i, Unit& u) const {
        const long L = (long)i * G + c; if (L >= nwg) return false;
        int wgid = (int)L; { const int q = nwg / NXCD, r = nwg % NXCD, xcd = wgid % NXCD, off = wgid / NXCD; wgid = (xcd < r ? xcd * (q + 1) : r * (q + 1) + (xcd - r) * q) + off; }
        const int nig = WGM * nN, gid = wgid / nig, fm = gid * WGM, gsz = (nM - fm) < WGM ? (nM - fm) : WGM;
        u.pm = fm + ((wgid % nig) % gsz); u.pn = (wgid % nig) / gsz; return true;
    }
    __device__ __forceinline__ void a_ready(const Unit&) const {}
    __device__ __forceinline__ void done(const Unit&) const {}
};
__device__ __forceinline__ unsigned cvt_pk_bf16(float lo, float hi) { unsigned r; asm volatile("v_cvt_pk_bf16_f32 %0, %1, %2" : "=v"(r) : "v"(lo), "v"(hi)); return r; }

#define PG8_GAS __attribute__((address_space(1)))
typedef unsigned u32x2 __attribute__((ext_vector_type(2)));
constexpr int TD = 1024, TW = 1536;
constexpr float NORM_EPS = 1e-6f;
__device__ __forceinline__ float fast_sigmoid(float x) { return __builtin_amdgcn_rcpf(1.0f + __builtin_amdgcn_exp2f(-1.4426950408889634f * x)); }
__device__ __forceinline__ float row_inv_rms(const float* part, int row, int fq) {
    const f32x4 pv = *(const PG8_GAS f32x4*)(part + (size_t)row * 16 + 4 * fq);
    float s = (pv[0] + pv[1]) + (pv[2] + pv[3]);
    s += __shfl_xor(s, 16); s += __shfl_xor(s, 32);
    return __builtin_amdgcn_rsqf(s * (1.0f / TD) + NORM_EPS);
}
__device__ __forceinline__ void fill_inv_table(PG8_LAS float* invt, int ui, int pm, const float* part) {
    const int r = threadIdx.x >> 1, hf = threadIdx.x & 1;
    const float* pp = part + (size_t)(pm * BM + r) * 16 + 8 * hf;
    const f32x4 a = *(const PG8_GAS f32x4*)pp, b = *(const PG8_GAS f32x4*)(pp + 4);
    float s = ((a[0] + a[1]) + (a[2] + a[3])) + ((b[0] + b[1]) + (b[2] + b[3]));
    s += __shfl_xor(s, 1);
    if (hf == 0) invt[ui * BM + r] = __builtin_amdgcn_rsqf(s * (1.0f / TD) + NORM_EPS);
}
__device__ __forceinline__ void fill_inv_table3(PG8_LAS float* invt, int ui, int pm0, int pm1, int pm2, bool h1, bool h2, const float* part) {
    const int r = threadIdx.x >> 1, hf = threadIdx.x & 1;
    const float* p0 = part + (size_t)(pm0 * BM + r) * 16 + 8 * hf; const float* p1 = part + (size_t)(pm1 * BM + r) * 16 + 8 * hf; const float* p2 = part + (size_t)(pm2 * BM + r) * 16 + 8 * hf;
    const f32x4 a0 = *(const PG8_GAS f32x4*)p0, b0 = *(const PG8_GAS f32x4*)(p0 + 4), a1 = *(const PG8_GAS f32x4*)p1, b1 = *(const PG8_GAS f32x4*)(p1 + 4), a2 = *(const PG8_GAS f32x4*)p2, b2 = *(const PG8_GAS f32x4*)(p2 + 4);
    float s0 = ((a0[0] + a0[1]) + (a0[2] + a0[3])) + ((b0[0] + b0[1]) + (b0[2] + b0[3]));
    float s1 = ((a1[0] + a1[1]) + (a1[2] + a1[3])) + ((b1[0] + b1[1]) + (b1[2] + b1[3]));
    float s2 = ((a2[0] + a2[1]) + (a2[2] + a2[3])) + ((b2[0] + b2[1]) + (b2[2] + b2[3]));
    s0 += __shfl_xor(s0, 1); s1 += __shfl_xor(s1, 1); s2 += __shfl_xor(s2, 1);
    if (hf == 0) { invt[ui * BM + r] = __builtin_amdgcn_rsqf(s0 * (1.0f / TD) + NORM_EPS);
        if (h1) invt[(ui + 1) * BM + r] = __builtin_amdgcn_rsqf(s1 * (1.0f / TD) + NORM_EPS);
        if (h2) invt[(ui + 2) * BM + r] = __builtin_amdgcn_rsqf(s2 * (1.0f / TD) + NORM_EPS); }
}
struct EpiInA {
    static constexpr bool PERM = true, AFTER_DRAIN = false;
    bf16_t* U; const PG8_LAS float* invt; mutable int cnt;
    __device__ __forceinline__ void operator()(const f32x4 (&acc)[2][2][4][2], const Unit& u, int wr, int wc, int fr, int fq) const {
        const int row0 = u.pm * BM + wr * 64 + fr, col0 = u.pn * BM + wc * 32 + 8 * fq;
#pragma unroll
        for (int ai = 0; ai < 2; ++ai)
#pragma unroll
            for (int m = 0; m < 4; ++m) {
                const int row = row0 + ai * HALF + m * 16;
                const float inv = invt[cnt * BM + wr * 64 + fr + ai * HALF + m * 16];
                bf16_t* rowp = U + (size_t)row * (2 * TW) + col0;
#pragma unroll
                for (int bj = 0; bj < 2; ++bj) {
                    const f32x4 v0 = acc[ai][bj][m][0] * inv, v1 = acc[ai][bj][m][1] * inv;
                    u32x4 w; w.x = cvt_pk_bf16(v0[0], v0[1]); w.y = cvt_pk_bf16(v0[2], v0[3]); w.z = cvt_pk_bf16(v1[0], v1[1]); w.w = cvt_pk_bf16(v1[2], v1[3]);
                    *(PG8_GAS u32x4*)(rowp + bj * HALF) = w;
                }
            }
        ++cnt;
    }
};
struct EpiInB {
    static constexpr bool PERM = false, AFTER_DRAIN = false;
    bf16_t* Y; const PG8_LAS float* invt; const float* cw; float* Ph; float* Qh; float* Ch; mutable int cnt;
    __device__ __forceinline__ void operator()(const f32x4 (&acc)[2][2][4][2], const Unit& u, int wr, int wc, int fr, int fq) const {
        const int row0 = u.pm * BM + wr * 64 + fr, ch0 = u.pn * 64 + wc * 16 + 4 * fq;
        const f32x4 w0 = *(const PG8_GAS f32x4*)(cw + ch0), w1 = *(const PG8_GAS f32x4*)(cw + TW + ch0), w2 = *(const PG8_GAS f32x4*)(cw + 2 * TW + ch0);
#pragma unroll
        for (int ai = 0; ai < 2; ++ai) {
            const int grp = u.pm * 4 + ai * 2 + wr;
            const bool seq_start = ((grp * 64) & 4095) == 0;
            f32x4 pprev = {0.f, 0.f, 0.f, 0.f};
#pragma unroll
            for (int m = 0; m < 4; ++m) {
                const int row = row0 + ai * HALF + m * 16;
                const float inv = invt[cnt * BM + wr * 64 + fr + ai * HALF + m * 16];
                const f32x4 bg = acc[ai][0][m][0] * inv, cgv = acc[ai][0][m][1] * inv, xv = acc[ai][1][m][0] * inv, gt = acc[ai][1][m][1] * inv;
                const f32x4 p = cgv * xv; f32x4 q, p1, p2;
#pragma unroll
                for (int e = 0; e < 4; ++e) { q[e] = bg[e] * gt[e] * fast_sigmoid(gt[e]);
                    p1[e] = __builtin_bit_cast(float, __builtin_amdgcn_update_dpp(0, __builtin_bit_cast(int, fr == 15 ? pprev[e] : p[e]), 0x121, 0xf, 0xf, false));
                    p2[e] = __builtin_bit_cast(float, __builtin_amdgcn_update_dpp(0, __builtin_bit_cast(int, fr >= 14 ? pprev[e] : p[e]), 0x122, 0xf, 0xf, false)); }
                const f32x4 cv = w0 * p2 + w1 * p1 + w2 * p, y = q * cv;
                u32x2 yw; yw.x = cvt_pk_bf16(y[0], y[1]); yw.y = cvt_pk_bf16(y[2], y[3]);
                *(PG8_GAS u32x2*)(Y + (size_t)row * TW + ch0) = yw;
                if (m == 0 && fr < 2 && !seq_start) { const size_t o = ((size_t)grp * 2 + fr) * TW + ch0; *(PG8_GAS f32x4*)(Qh + o) = q; *(PG8_GAS f32x4*)(Ch + o) = cv; }
                if (m == 3 && fr >= 14) { const size_t o = ((size_t)grp * 2 + (fr - 14)) * TW + ch0; *(PG8_GAS f32x4*)(Ph + o) = p; }
                pprev = p;
            }
        }
        ++cnt;
    }
};
__device__ __forceinline__ void convb_fixup(int pm, bf16_t* Y, const float* cw, const float* Ph, const float* Qh, const float* Ch) {
    for (int it = threadIdx.x; it < 4 * 2 * (TW / 4); it += 512) {
        const int c4 = it % (TW / 4), rr = (it / (TW / 4)) & 1, g = it / (2 * (TW / 4)), grp = pm * 4 + g, ch = 4 * c4;
        if (((grp * 64) & 4095) == 0) continue;
        const size_t o = ((size_t)grp * 2 + rr) * TW + ch, op = ((size_t)(grp - 1) * 2) * TW + ch;
        const f32x4 q = *(const PG8_GAS f32x4*)(Qh + o); f32x4 cv = *(const PG8_GAS f32x4*)(Ch + o);
        const f32x4 w0 = *(const PG8_GAS f32x4*)(cw + ch), w1 = *(const PG8_GAS f32x4*)(cw + TW + ch);
        const f32x4 pa = *(const PG8_GAS f32x4*)(Ph + op), pb = *(const PG8_GAS f32x4*)(Ph + op + TW);
        if (rr == 0) cv += w0 * pa + w1 * pb; else cv += w0 * pb;
        const f32x4 y = q * cv;
        u32x2 yw; yw.x = cvt_pk_bf16(y[0], y[1]); yw.y = cvt_pk_bf16(y[2], y[3]);
        *(PG8_GAS u32x2*)(Y + ((size_t)grp * 64 + rr) * TW + ch) = yw;
    }
}
struct EpiOut {
    static constexpr bool PERM = true, AFTER_DRAIN = false;
    bf16_t* x16; float* part;
    __device__ __forceinline__ void operator()(const f32x4 (&acc)[2][2][4][2], const Unit& u, int wr, int wc, int fr, int fq) const {
        const int row0 = u.pm * BM + wr * 64 + fr, col0 = u.pn * BM + wc * 32 + 8 * fq;
#pragma unroll
        for (int ai = 0; ai < 2; ++ai)
#pragma unroll
            for (int m = 0; m < 4; ++m) {
                const int row = row0 + ai * HALF + m * 16;
                bf16_t* rowp = x16 + (size_t)row * TD + col0;
                float ss = 0.f;
#pragma unroll
                for (int bj = 0; bj < 2; ++bj) {
                    const u32x4 rv = *(const PG8_GAS u32x4*)(rowp + bj * HALF);
                    const f32x4 r0 = {__builtin_bit_cast(float, rv.x << 16), __builtin_bit_cast(float, rv.x & 0xffff0000u), __builtin_bit_cast(float, rv.y << 16), __builtin_bit_cast(float, rv.y & 0xffff0000u)};
                    const f32x4 r1 = {__builtin_bit_cast(float, rv.z << 16), __builtin_bit_cast(float, rv.z & 0xffff0000u), __builtin_bit_cast(float, rv.w << 16), __builtin_bit_cast(float, rv.w & 0xffff0000u)};
                    const f32x4 v0 = acc[ai][bj][m][0] + r0, v1 = acc[ai][bj][m][1] + r1;
                    u32x4 w; w.x = cvt_pk_bf16(v0[0], v0[1]); w.y = cvt_pk_bf16(v0[2], v0[3]); w.z = cvt_pk_bf16(v1[0], v1[1]); w.w = cvt_pk_bf16(v1[2], v1[3]);
                    *(PG8_GAS u32x4*)(rowp + bj * HALF) = w;
                    const unsigned ww[4] = {w.x, w.y, w.z, w.w};
#pragma unroll
                    for (int e = 0; e < 4; ++e) { const float a = __builtin_bit_cast(float, ww[e] << 16), b = __builtin_bit_cast(float, ww[e] & 0xffff0000u); ss += a * a + b * b; }
                }
                ss += __shfl_xor(ss, 16); ss += __shfl_xor(ss, 32);
                if (fq == 0) *(PG8_GAS float*)(part + (size_t)row * 16 + 4 * u.pn + wc) = ss;
            }
    }
};
template <class Epi, class Sched, bool ALIGN_EPI = false, bool SP2 = false>
__device__ __forceinline__ void gemm_phase(PG8_LAS unsigned char* lds, const Gemm g, const Sched& S, const Epi& E) {
    int tid_ = threadIdx.x; asm volatile("" : "+v"(tid_));
    const int tid = tid_, wid = __builtin_amdgcn_readfirstlane(tid >> 6), lane = tid & 63, wr = wid >> 2, wc = wid & 3, fr = lane & 15, fq = lane >> 4;
    const int K = g.K, nt = K / BK;
    unsigned voffA[2], voffB[2];
#pragma unroll
    for (int i = 0; i < 2; ++i) { int R, C; stage_rc(tid * 16 + i * 8192, R, C); const int Rb = Epi::PERM ? ((R & ~31) + perm32(R & 31)) : R;
        voffA[i] = (unsigned)(R * K + C) * 2u; voffB[i] = (unsigned)(Rb * K + C) * 2u; }
    const size_t kstep = (size_t)(BK * 2);
    const size_t hstep = (size_t)HALF * K * 2;
    const size_t tstep = 2 * hstep;
    const unsigned ldsw = (unsigned)wid * 1024u;
    const int aoff = lds_byte(wr * 64 + fr, fq * 8), boff = lds_byte(wc * 32 + fr, fq * 8);
#define PG8_SA(b, h) (((b) * 2 + (h)) * HTB)
#define PG8_SB(b, h) ((4 + (b) * 2 + (h)) * HTB)
#define PG8_STAGE(bufoff, gbase, voff) do { _Pragma("unroll") for (int _i = 0; _i < 2; ++_i) \
        __builtin_amdgcn_global_load_lds((const unsigned*)((const char*)(gbase) + (voff)[_i]), (PG8_LAS unsigned*)(lds + (bufoff) + ldsw + _i * 8192), 16, 0, 0); } while (0)
#define PG8_LDA(dst, b, h) do { _Pragma("unroll") for (int m = 0; m < 4; ++m) _Pragma("unroll") for (int k = 0; k < 2; ++k) dst[m][k] = *(const PG8_LAS bf16x8*)(lds + PG8_SA(b, h) + aoff + m * 2048 + k * 1024); } while (0)
#define PG8_LDB(dst, b, h) do { _Pragma("unroll") for (int n = 0; n < 2; ++n) _Pragma("unroll") for (int k = 0; k < 2; ++k) dst[n][k] = *(const PG8_LAS bf16x8*)(lds + PG8_SB(b, h) + boff + n * 2048 + k * 1024); } while (0)
#define PG8_MMA(ai, bj, At, Bt) do { __builtin_amdgcn_s_setprio(1); _Pragma("unroll") for (int m = 0; m < 4; ++m) _Pragma("unroll") for (int n = 0; n < 2; ++n) _Pragma("unroll") for (int k = 0; k < 2; ++k) \
        acc[ai][bj][m][n] = __builtin_amdgcn_mfma_f32_16x16x32_bf16(Bt[n][k], At[m][k], acc[ai][bj][m][n], 0, 0, 0); __builtin_amdgcn_s_setprio(0); } while (0)
#define PG8_WAIT_V(n) asm volatile("s_waitcnt vmcnt(" #n ")" ::: "memory")
#define PG8_WAIT_L(n) asm volatile("s_waitcnt lgkmcnt(" #n ")" ::: "memory")
#define PG8_BAR __builtin_amdgcn_s_barrier()
#define PG8_SCHED __builtin_amdgcn_sched_barrier(0)
    Unit cur, nxt; int ui = 0;
    if (!S.next(0, cur)) return;
    f32x4 acc[2][2][4][2];
#pragma unroll
    for (int a = 0; a < 2; ++a)
#pragma unroll
        for (int b = 0; b < 2; ++b)
#pragma unroll
            for (int m = 0; m < 4; ++m)
#pragma unroll
                for (int n = 0; n < 2; ++n) acc[a][b][m][n] = (f32x4){0.f, 0.f, 0.f, 0.f};
    bf16x8 At[4][2], B0[2][2], B1[2][2];
    const char* cA = (const char*)g.A + (size_t)cur.pm * tstep; const char* cB = (const char*)g.Bt + (size_t)cur.pn * tstep;
    S.a_ready(cur);
    if constexpr (SP2) {
        PG8_STAGE(PG8_SB(0, 0), cB, voffB); PG8_STAGE(PG8_SB(0, 1), cB + hstep, voffB); PG8_STAGE(PG8_SA(0, 0), cA, voffA); PG8_STAGE(PG8_SA(0, 1), cA + hstep, voffA);
        if (wr == 1) PG8_BAR;
        PG8_WAIT_V(2); PG8_BAR;
        PG8_STAGE(PG8_SB(1, 0), cB + kstep, voffB); PG8_STAGE(PG8_SA(1, 0), cA + kstep, voffA); PG8_STAGE(PG8_SB(1, 1), cB + hstep + kstep, voffB);
        PG8_WAIT_V(6); PG8_BAR;
    } else {
        PG8_STAGE(PG8_SB(0, 0), cB, voffB); PG8_STAGE(PG8_SA(0, 0), cA, voffA); PG8_STAGE(PG8_SB(0, 1), cB + hstep, voffB); PG8_STAGE(PG8_SA(0, 1), cA + hstep, voffA);
        if (wr == 1) PG8_BAR;
        PG8_WAIT_V(4); PG8_BAR;
        PG8_STAGE(PG8_SB(1, 0), cB + kstep, voffB); PG8_STAGE(PG8_SA(1, 0), cA + kstep, voffA); PG8_STAGE(PG8_SB(1, 1), cB + hstep + kstep, voffB);
        PG8_WAIT_V(6); PG8_BAR;
    }
    for (;;) {
        const bool has_next = S.next(ui + 1, nxt);
        const char* nA = has_next ? (const char*)g.A + (size_t)nxt.pm * tstep : cA; const char* nB = has_next ? (const char*)g.Bt + (size_t)nxt.pn * tstep : cB;
        for (int t = 0; t < nt; t += 2) {
            const bool last = (t == nt - 2);
            const char* a1 = cA + (size_t)(t + 1) * kstep;
            const char* a2 = last ? nA : cA + (size_t)(t + 2) * kstep; const char* b2 = last ? nB : cB + (size_t)(t + 2) * kstep;
            const char* a3 = a2 + kstep; const char* b3 = b2 + kstep;
            if (last && has_next) S.a_ready(nxt);
            if constexpr (SP2) {
            PG8_LDB(B0, 0, 0); PG8_LDB(B1, 0, 1); PG8_SCHED; PG8_LDA(At, 0, 0); PG8_STAGE(PG8_SA(1, 1), a1 + hstep, voffA);
            PG8_WAIT_V(8); PG8_WAIT_L(0); PG8_BAR; PG8_MMA(0, 0, At, B0); PG8_MMA(0, 1, At, B1); PG8_BAR; PG8_SCHED;
            PG8_LDA(At, 0, 1); PG8_STAGE(PG8_SB(0, 0), b2, voffB); PG8_STAGE(PG8_SB(0, 1), b2 + hstep, voffB); PG8_STAGE(PG8_SA(0, 0), a2, voffA);
            PG8_WAIT_V(8); PG8_WAIT_L(0); PG8_BAR; PG8_MMA(1, 0, At, B0); PG8_MMA(1, 1, At, B1); PG8_BAR; PG8_SCHED;
            PG8_LDB(B0, 1, 0); PG8_LDB(B1, 1, 1); PG8_SCHED; PG8_LDA(At, 1, 0); PG8_STAGE(PG8_SA(0, 1), a2 + hstep, voffA);
            PG8_WAIT_V(8); PG8_WAIT_L(0); PG8_BAR; PG8_MMA(0, 0, At, B0); PG8_MMA(0, 1, At, B1); PG8_BAR; PG8_SCHED;
            PG8_LDA(At, 1, 1); PG8_STAGE(PG8_SB(1, 0), b3, voffB); PG8_STAGE(PG8_SB(1, 1), b3 + hstep, voffB); PG8_STAGE(PG8_SA(1, 0), a3, voffA);
            PG8_WAIT_V(8); PG8_WAIT_L(0); PG8_BAR; PG8_MMA(1, 0, At, B0); PG8_MMA(1, 1, At, B1); PG8_BAR; PG8_SCHED;
            } else {
            PG8_LDB(B0, 0, 0); PG8_SCHED; PG8_LDA(At, 0, 0); PG8_STAGE(PG8_SA(1, 1), a1 + hstep, voffA);
            PG8_WAIT_L(8); PG8_BAR; PG8_WAIT_L(0); PG8_MMA(0, 0, At, B0); PG8_BAR; PG8_SCHED;
            PG8_LDB(B1, 0, 1); PG8_STAGE(PG8_SB(0, 0), b2, voffB);
            PG8_BAR; PG8_WAIT_L(0); PG8_MMA(0, 1, At, B1); PG8_BAR;
            PG8_LDA(At, 0, 1); PG8_STAGE(PG8_SA(0, 0), a2, voffA);
            PG8_BAR; PG8_WAIT_L(0); PG8_MMA(1, 0, At, B0); PG8_BAR; PG8_SCHED;
            PG8_STAGE(PG8_SB(0, 1), b2 + hstep, voffB);
            PG8_WAIT_V(6); PG8_BAR; PG8_MMA(1, 1, At, B1); PG8_BAR;
            PG8_LDB(B0, 1, 0); PG8_SCHED; PG8_LDA(At, 1, 0); PG8_STAGE(PG8_SA(0, 1), a2 + hstep, voffA);
            PG8_WAIT_L(8); PG8_BAR; PG8_WAIT_L(0); PG8_MMA(0, 0, At, B0); PG8_BAR; PG8_SCHED;
            PG8_LDB(B1, 1, 1); PG8_STAGE(PG8_SB(1, 0), b3, voffB);
            PG8_BAR; PG8_WAIT_L(0); PG8_MMA(0, 1, At, B1); PG8_BAR;
            PG8_LDA(At, 1, 1); PG8_STAGE(PG8_SA(1, 0), a3, voffA);
            PG8_BAR; PG8_WAIT_L(0); PG8_MMA(1, 0, At, B0); PG8_BAR; PG8_SCHED;
            PG8_STAGE(PG8_SB(1, 1), b3 + hstep, voffB);
            PG8_WAIT_V(6); PG8_BAR; PG8_MMA(1, 1, At, B1); PG8_BAR;
            }
        }
        if constexpr (ALIGN_EPI) { if (wr == 0) PG8_BAR; }
        if constexpr (!Epi::AFTER_DRAIN) { E(acc, cur, wr, wc, fr, fq); S.done(cur); }
        if (!has_next) break;
#pragma unroll
        for (int a = 0; a < 2; ++a)
#pragma unroll
            for (int b = 0; b < 2; ++b)
#pragma unroll
                for (int m = 0; m < 4; ++m)
#pragma unroll
                    for (int n = 0; n < 2; ++n) acc[a][b][m][n] = (f32x4){0.f, 0.f, 0.f, 0.f};
        cur = nxt; cA = nA; cB = nB; ++ui;
        if constexpr (ALIGN_EPI) { if (wr == 1) PG8_BAR; }
    }
    PG8_WAIT_V(0);
    if constexpr (!ALIGN_EPI) { if (wr == 0) PG8_BAR; }
    PG8_BAR;
    if constexpr (Epi::AFTER_DRAIN) { E.fused(acc, cur, wr, wc, fr, fq, lds, wid, lane); S.done(cur); }
#undef PG8_SA
#undef PG8_SB
#undef PG8_STAGE
#undef PG8_LDA
#undef PG8_LDB
#undef PG8_MMA
#undef PG8_WAIT_V
#undef PG8_WAIT_L
#undef PG8_BAR
#undef PG8_SCHED
}
}

namespace cg = cooperative_groups;
#define LAS __attribute__((address_space(3)))
#define GAS __attribute__((address_space(1)))
typedef unsigned short bf16;
typedef unsigned v4u __attribute__((ext_vector_type(4)));
typedef unsigned v2u __attribute__((ext_vector_type(2)));
typedef float f32x4 __attribute__((ext_vector_type(4)));
typedef short bf16x8 __attribute__((ext_vector_type(8)));
#define LDS_WAIT() asm volatile("s_waitcnt lgkmcnt(0)" ::: "memory")

constexpr int NWAVES = 8;
constexpr int NB = 8, SEQ = 4096, T = NB * SEQ, D = 1024, W = 1536, NH = 12;
constexpr int CHUNK = 256, NCHUNK = SEQ / CHUNK;
constexpr float EPS = 1e-6f;
constexpr size_t MiB = 1u << 20;
constexpr size_t WS_X16 = 0;
constexpr size_t WS_U = 64 * MiB;
constexpr size_t WS_Y = 256 * MiB;
constexpr size_t WS_WINA = 352 * MiB;
constexpr size_t WS_WOUTA = 364 * MiB;
constexpr size_t WS_WINB = 370 * MiB;
constexpr size_t WS_WOUTB = 394 * MiB;
constexpr size_t WS_GW = 400 * MiB;
constexpr size_t WS_PART = 402 * MiB;
constexpr size_t WS_SP = 412 * MiB;
constexpr size_t WS_CTL = 413 * MiB;
constexpr size_t WS_GRAN = WS_CTL + 16384;
constexpr size_t CTL_BYTES = 16384 + (size_t)8 * 16 * 1536 * 8;
constexpr size_t WS_PH = 416 * MiB, WS_QH = 424 * MiB, WS_CHH = 432 * MiB;
constexpr size_t WS_END = 440 * MiB;
constexpr int LDS_BYTES = 147456;
constexpr int MISC_OFF = LDS_BYTES - 256;
constexpr int XP = 272;

__device__ __forceinline__ float bf2f(unsigned short b) { return __builtin_bit_cast(float, (unsigned)b << 16); }
__device__ __forceinline__ float bflo(unsigned u) { return __builtin_bit_cast(float, u << 16); }
__device__ __forceinline__ float bfhi(unsigned u) { return __builtin_bit_cast(float, u & 0xffff0000u); }
__device__ __forceinline__ unsigned pk2(float lo, float hi) { return pg8::cvt_pk_bf16(lo, hi); }
constexpr float L2E = 1.4426950408889634f;
__device__ __forceinline__ float sigm(float x) { return __builtin_amdgcn_rcpf(1.0f + __builtin_amdgcn_exp2f(-L2E * x)); }
__device__ __forceinline__ float wave_sum(float v) {
#pragma unroll
    for (int o = 1; o < 64; o <<= 1) v += __shfl_xor(v, o);
    return v;
}

#define XB_TMO      128
#define XB_XCNT(j)  (256  + 64 * (j))
#define XB_XSUB(j)  (1280 + 64 * (j))
#define XB_XGEN(j)  (2304 + 64 * (j))
#define XB_TOP      3328
#define XB_TOPGEN   3392
#define XCD_BAR_WORDS 3456
#define XB_SPIN_CAP (1u << 18)

__device__ __forceinline__ unsigned xb_ld(unsigned* p)              { return __hip_atomic_load(p, __ATOMIC_RELAXED, __HIP_MEMORY_SCOPE_AGENT); }
__device__ __forceinline__ unsigned xb_add(unsigned* p, unsigned v) { return __hip_atomic_fetch_add(p, v, __ATOMIC_RELAXED, __HIP_MEMORY_SCOPE_AGENT); }
__device__ __forceinline__ unsigned xb_xcc_id() { return (unsigned)__builtin_amdgcn_s_getreg((3 << 11) | 20) & 0xFu; }
#define XB_SPIN(cond, bar) do { unsigned _sp = 0; while (cond) { __builtin_amdgcn_s_sleep(1); \
    if ((++_sp & 255u) == 0u) { if (xb_ld(&(bar)[XB_TMO])) break; if (_sp > XB_SPIN_CAP) { atomicAdd(&(bar)[XB_TMO], 1u); break; } } } } while (0)

struct XcdBarrier {
    unsigned* bar; unsigned x;
    volatile LAS unsigned* st;
};

__device__ __forceinline__ XcdBarrier xcd_barrier_post(unsigned* bar, volatile LAS unsigned* st) {
    XcdBarrier b; b.bar = bar; b.x = xb_xcc_id(); b.st = st;
    if (threadIdx.x == 0) (void)xb_add(&bar[XB_XCNT(b.x)], 1u);
    return b;
}
__device__ __forceinline__ void xcd_barrier_complete(unsigned* bar, unsigned x, unsigned& nloc, unsigned& nx) {
    const unsigned G = gridDim.x * gridDim.y * gridDim.z;
    unsigned sum, cnt, mine, sp = 0u;
    for (;;) {
        sum = 0u; cnt = 0u; mine = 0u;
#pragma unroll
        for (unsigned j = 0; j < 16; ++j) { const unsigned c = xb_ld(&bar[XB_XCNT(j)]); sum += c; cnt += (c > 0u) ? 1u : 0u; mine = (j == x) ? c : mine; }
        if (sum == G) break;
        __builtin_amdgcn_s_sleep(1);
        if ((++sp & 255u) == 0u) { if (xb_ld(&bar[XB_TMO])) break; if (sp > XB_SPIN_CAP) { atomicAdd(&bar[XB_TMO], 1u); break; } }
    }
    nloc = mine > 0u ? mine : 1u; nx = cnt > 0u ? cnt : 1u;
}

__device__ __forceinline__ void xcd_barrier(const XcdBarrier& b) {
    asm volatile("s_waitcnt vmcnt(0)" ::: "memory");
    __syncthreads();
    if (threadIdx.x == 0) {
        unsigned* bar = b.bar;
        __builtin_amdgcn_s_waitcnt(0);
        unsigned nloc = b.st[0], nx = b.st[1];
        if (nloc == 0u) { xcd_barrier_complete(bar, b.x, nloc, nx); b.st[0] = nloc; b.st[1] = nx; }
        const unsigned old = xb_add(&bar[XB_XSUB(b.x)], 1u);
        const unsigned gen = old / nloc;
        if (old + 1u == (gen + 1u) * nloc) {
            __builtin_amdgcn_fence(__ATOMIC_RELEASE, "agent");
            asm volatile("s_waitcnt vmcnt(0)" ::: "memory");
            const unsigned og = xb_add(&bar[XB_TOP], 1u);
            const unsigned tg = og / nx;
            if (og + 1u == (tg + 1u) * nx) xb_add(&bar[XB_TOPGEN], 1u);
            else XB_SPIN(xb_ld(&bar[XB_TOPGEN]) == tg, bar);
            __builtin_amdgcn_fence(__ATOMIC_ACQUIRE, "agent");
            xb_add(&bar[XB_XGEN(b.x)], 1u);
            asm volatile("s_waitcnt vmcnt(0)" ::: "memory");
        } else {
            XB_SPIN(xb_ld(&bar[XB_XGEN(b.x)]) == gen, bar);
            __builtin_amdgcn_fence(__ATOMIC_ACQUIRE, "agent");
            asm volatile("s_waitcnt vmcnt(0)" ::: "memory");
        }
    }
    __syncthreads();
}

template <int MAP>
__device__ __forceinline__ void transpose_item(const float* Wsrc, int K, int N, const float* scale, bf16* WT, LAS float* scr, int item, int lane) {
    const int nblk = N / 32, kb = item / nblk, nb = item % nblk, k0 = 64 * kb, n0 = 32 * nb;
    float tv[32];
#pragma unroll
    for (int i = 0; i < 32; ++i) { const int kk = 2 * i + (lane >> 5);
        tv[i] = __builtin_nontemporal_load((const GAS float*)(Wsrc + (size_t)(k0 + kk) * N + n0 + (lane & 31))); }
#pragma unroll
    for (int i = 0; i < 32; ++i) { const int kk = 2 * i + (lane >> 5);
        float v = tv[i];
        if (scale) v *= *(const GAS float*)(scale + k0 + kk);
        scr[kk * 33 + (lane & 31)] = v; }
    LDS_WAIT(); asm volatile("" ::: "memory");
    const int c = lane & 7;
#pragma unroll
    for (int jj = 0; jj < 4; ++jj) { const int n = (lane >> 3) + 8 * jj; const LAS float* s = scr + (8 * c) * 33 + n;
        v4u o; o.x = pk2(s[0 * 33], s[1 * 33]); o.y = pk2(s[2 * 33], s[3 * 33]); o.z = pk2(s[4 * 33], s[5 * 33]); o.w = pk2(s[6 * 33], s[7 * 33]);
        int dn = n0 + n;
        if (MAP == 1) { const int type = dn / W, chn = dn % W, pn = chn >> 6, r64 = chn & 63, wc = r64 >> 4, low = r64 & 15;
            dn = 256 * pn + 128 * (type >> 1) + 32 * wc + 16 * (type & 1) + low; }
        *(GAS v4u*)(WT + (size_t)dn * K + k0 + 8 * c) = o; }
    LDS_WAIT(); asm volatile("" ::: "memory");
}

struct Args { const float* in[13]; float* out; unsigned char* ws; int ph_lo, ph_hi; };

__device__ __forceinline__ void prologue(const Args& a, LAS unsigned char* lds, int gw, int NGW, int lane, int wave) {
    unsigned char* ws = a.ws;
    LAS float* scr = (LAS float*)(lds + wave * 16384);
    constexpr int IA_IN = 16 * 96, IA_OUT = 24 * 32, IB_IN = 16 * 192, IB_OUT = 24 * 32, IG = 12 * 16, IPJ = IA_IN + IA_OUT + IB_IN + IB_OUT + IG;
    for (int it = gw; it < 2 * IPJ; it += NGW) {
        const int j = it / IPJ; int r = it % IPJ;
        if (r < IA_IN) { transpose_item<0>(a.in[2] + (size_t)j * D * 2 * W, D, 2 * W, a.in[1] + (size_t)(2 * j) * D, (bf16*)(ws + WS_WINA) + (size_t)j * 2 * W * D, scr, r, lane); continue; } r -= IA_IN;
        if (r < IA_OUT) { transpose_item<0>(a.in[8] + (size_t)j * W * D, W, D, nullptr, (bf16*)(ws + WS_WOUTA) + (size_t)j * D * W, scr, r, lane); continue; } r -= IA_OUT;
        if (r < IB_IN) { transpose_item<1>(a.in[9] + (size_t)j * D * 4 * W, D, 4 * W, a.in[1] + (size_t)(2 * j + 1) * D, (bf16*)(ws + WS_WINB) + (size_t)j * 4 * W * D, scr, r, lane); continue; } r -= IB_IN;
        if (r < IB_OUT) { transpose_item<0>(a.in[11] + (size_t)j * W * D, W, D, nullptr, (bf16*)(ws + WS_WOUTB) + (size_t)j * D * W, scr, r, lane); continue; } r -= IB_OUT;
        { const int h = r / 16, ri = r % 16;
          transpose_item<0>(a.in[5] + (size_t)(j * NH + h) * 128 * 256, 128, 256, nullptr, (bf16*)(ws + WS_GW) + (size_t)(j * NH + h) * 256 * 128, scr, ri, lane); }
    }
    const float* x = a.in[0]; bf16* x16 = (bf16*)(ws + WS_X16); float* part = (float*)(ws + WS_PART);
    for (int m = gw; m < T; m += NGW) {
        const GAS f32x4* xr = (const GAS f32x4*)(x + (size_t)m * D) + lane;
        f32x4 v[4]; float s = 0.f;
#pragma unroll
        for (int jj = 0; jj < 4; ++jj) { v[jj] = __builtin_nontemporal_load(xr + 64 * jj); s += (v[jj][0] * v[jj][0] + v[jj][1] * v[jj][1]) + (v[jj][2] * v[jj][2] + v[jj][3] * v[jj][3]); }
        s = wave_sum(s);
        GAS v2u* o8 = (GAS v2u*)(x16 + (size_t)m * D) + lane;
#pragma unroll
        for (int jj = 0; jj < 4; ++jj) { v2u o; o.x = pk2(v[jj][0], v[jj][1]); o.y = pk2(v[jj][2], v[jj][3]); o8[64 * jj] = o; }
        if (lane < 16) *(GAS float*)(part + (size_t)m * 16 + lane) = (lane == 0) ? s : 0.f;
    }
    for (int i = gw * 64 + lane; i < 2 * W; i += NGW * 64) *(GAS float*)((float*)(ws + WS_SP) + i) = log1pf(expf(-a.in[7][i]));
}

__device__ __forceinline__ void scan_single(LAS unsigned char* lds, const bf16* U, bf16* Y, const bf16* GWl, const float* gate_b, const float* conv_w, const float* conv_b,
                                            const float* sp, unsigned long long* gran, unsigned epoch) {
    int tid_ = threadIdx.x; asm volatile("" : "+v"(tid_));
    const int tid = tid_, lane = tid & 63, w = __builtin_amdgcn_readfirstlane(tid >> 6), j = lane & 15, q = lane >> 4;
    LAS unsigned char* xcs = lds; LAS unsigned char* gts = lds + 256 * XP;
    const int cgp = tid & 15, tg = tid >> 4;
    v4u xr[11];
#define SC_ISSUE(it_) do { const int bh_ = (it_) % (NB * NH), c_ = (it_) / (NB * NH), h_ = bh_ % NH, b_ = bh_ / NH; const size_t g0_ = (size_t)b_ * SEQ + (size_t)CHUNK * c_; const int ch_ = 128 * h_ + 8 * cgp, tl0_ = 8 * tg; \
        _Pragma("unroll") for (int r = 0; r < 11; ++r) { const int tl = tl0_ - 3 + r; if (CHUNK * c_ + tl >= 0) xr[r] = __builtin_nontemporal_load((const GAS v4u*)(U + (g0_ + tl) * (size_t)(2 * W) + W + ch_)); else xr[r] = (v4u){0u, 0u, 0u, 0u}; } \
        } while (0)
    if ((int)blockIdx.x < NB * NCHUNK * NH) SC_ISSUE((int)blockIdx.x);
    for (int item = blockIdx.x; item < NB * NCHUNK * NH; item += gridDim.x) {
        const int bh = item % (NB * NH), c = item / (NB * NH), h = bh % NH, b = bh / NH;
        const size_t grow0 = (size_t)b * SEQ + (size_t)CHUNK * c;
        GAS unsigned long long* gI = (GAS unsigned long long*)gran;
        const int chl = 128 * h + 16 * w + j;
        unsigned long long xi_pre = 0ull;
        if (c > 0) xi_pre = __hip_atomic_load(gI + ((size_t)b * NCHUNK + (c - 1)) * W + chl, __ATOMIC_RELAXED, __HIP_MEMORY_SCOPE_AGENT);
        {
            const int tl0 = 8 * tg, ch = 128 * h + 8 * cgp;
            v4u gr[8];
#pragma unroll
            for (int t = 0; t < 8; ++t) gr[t] = __builtin_nontemporal_load((const GAS v4u*)(U + (grow0 + tl0 + t) * (size_t)(2 * W) + ch));
            f32x4 wk[4][2], bs[2];
#pragma unroll
            for (int k = 0; k < 4; ++k) { wk[k][0] = *(const GAS f32x4*)(conv_w + (size_t)k * W + ch); wk[k][1] = *(const GAS f32x4*)(conv_w + (size_t)k * W + ch + 4); }
            bs[0] = *(const GAS f32x4*)(conv_b + ch); bs[1] = *(const GAS f32x4*)(conv_b + ch + 4);
#pragma unroll
            for (int t = 0; t < 8; ++t) {
                f32x4 o0 = bs[0], o1 = bs[1];
#pragma unroll
                for (int k = 0; k < 4; ++k) { const v4u xv = xr[t + k];
                    o0 += wk[k][0] * (f32x4){bflo(xv.x), bfhi(xv.x), bflo(xv.y), bfhi(xv.y)};
                    o1 += wk[k][1] * (f32x4){bflo(xv.z), bfhi(xv.z), bflo(xv.w), bfhi(xv.w)}; }
                const int tl = tl0 + t, R = 16 * ((tl >> 2) & 15) + 4 * (tl >> 6) + (tl & 3);
                v4u o; o.x = pk2(o0[0], o0[1]); o.y = pk2(o0[2], o0[3]); o.z = pk2(o1[0], o1[1]); o.w = pk2(o1[2], o1[3]);
                *(LAS v4u*)(xcs + R * XP + 16 * cgp) = o;
                *(LAS v4u*)(gts + R * XP + 16 * cgp) = gr[t];
            }
        }
        bf16x8 br[4], bi[4];
        { const bf16* gwr = GWl + ((size_t)(h * 256 + 16 * w + j) * 128 + 8 * q); const bf16* gwi = gwr + 128 * 128;
#pragma unroll
          for (int kk = 0; kk < 4; ++kk) { br[kk] = *(const GAS bf16x8*)(gwr + 32 * kk); bi[kk] = *(const GAS bf16x8*)(gwi + 32 * kk); } }
        const float gbr = *(const GAS float*)(gate_b + h * 256 + 16 * w + j), gbi = *(const GAS float*)(gate_b + h * 256 + 128 + 16 * w + j);
        const float c8 = -8.0f * L2E * *(const GAS float*)(sp + chl);
        const float gbrL = -L2E * gbr, gbiL = -L2E * gbi;
        __syncthreads();
        const LAS unsigned char* xel = xcs + (4 * q) * XP + 2 * (16 * w + j);
        LAS unsigned char* gel = gts + (4 * q) * XP + 2 * (16 * w + j);
        unsigned ps[16][2]; float Pq = 1.f, hl = 0.f; float pprev = 0.f;
        bf16x8 Af[2][4]; f32x4 accR[2], accI[2]; unsigned short xv_[2][4], gv_[2][4];
#define SC_LOAD_A(buf, mm) do { const LAS unsigned char* arow_ = xcs + (16 * (mm) + j) * XP + 16 * q; _Pragma("unroll") for (int kk = 0; kk < 4; ++kk) Af[buf][kk] = *(const LAS bf16x8*)(arow_ + 64 * kk); } while (0)
#define SC_LOAD_XG(buf, mm) do { _Pragma("unroll") for (int i = 0; i < 4; ++i) { xv_[buf][i] = *(const LAS unsigned short*)(xel + (16 * (mm) + i) * XP); gv_[buf][i] = *(const LAS unsigned short*)(gel + (16 * (mm) + i) * XP); } } while (0)
#define SC_MFMA(buf) do { accR[buf] = (f32x4){0.f, 0.f, 0.f, 0.f}; accI[buf] = (f32x4){0.f, 0.f, 0.f, 0.f}; _Pragma("unroll") for (int kk = 0; kk < 4; ++kk) { \
            accR[buf] = __builtin_amdgcn_mfma_f32_16x16x32_bf16(Af[buf][kk], br[kk], accR[buf], 0, 0, 0); accI[buf] = __builtin_amdgcn_mfma_f32_16x16x32_bf16(Af[buf][kk], bi[kk], accI[buf], 0, 0, 0); } } while (0)
        SC_LOAD_A(0, 0); SC_LOAD_XG(0, 0); SC_LOAD_A(1, 1); SC_MFMA(0);
#pragma unroll
        for (int m = 0; m < 16; ++m) {
            const int cur = m & 1, nxt = cur ^ 1;
            if (m + 1 < 16) { SC_MFMA(nxt); SC_LOAD_XG(nxt, m + 1); }
            if (m + 2 < 16) SC_LOAD_A(cur, m + 2);
#pragma unroll
            for (int i = 0; i < 4; ++i) {
                const float xcv = bf2f(xv_[cur][i]);
                const float g = bf2f(gv_[cur][i]);
                const float r = __builtin_amdgcn_rcpf(1.0f + __builtin_amdgcn_exp2f(__builtin_fmaf(accR[cur][i], -L2E, gbrL)));
                const float ig = __builtin_amdgcn_rcpf(1.0f + __builtin_amdgcn_exp2f(__builtin_fmaf(accI[cur][i], -L2E, gbiL)));
                const float av = __builtin_amdgcn_exp2f(c8 * r);
                const float mult = __builtin_amdgcn_sqrtf(__builtin_fmaf(-av, av, 1.0f));
                const float bt = mult * (ig * xcv);
                const float sg = g * __builtin_amdgcn_rcpf(1.0f + __builtin_amdgcn_exp2f(-L2E * g));
                hl = av * hl + bt; Pq *= av;
                *(LAS unsigned short*)(gel + (16 * m + i) * XP) = (unsigned short)(pk2(hl * sg, 0.f) & 0xffffu);
                { const float pv = Pq * sg; if (i & 1) ps[m][i >> 1] = pk2(pprev, pv); else pprev = pv; }
            }
        }
#undef SC_LOAD_A
#undef SC_LOAD_XG
#undef SC_MFMA
        if (item + (int)gridDim.x < NB * NCHUNK * NH) SC_ISSUE(item + (int)gridDim.x);
        const float A0 = __shfl(Pq, j), B0 = __shfl(hl, j), A1 = __shfl(Pq, 16 + j), B1 = __shfl(hl, 16 + j), A2 = __shfl(Pq, 32 + j), B2 = __shfl(hl, 32 + j), A3 = __shfl(Pq, 48 + j), B3 = __shfl(hl, 48 + j);
        const float E2A = A1 * A0, E2B = A1 * B0 + B1, E3A = A2 * E2A, E3B = A2 * E2B + B2, TA = A3 * E3A, TB = A3 * E3B + B3;
        const float EA = q == 0 ? 1.f : (q == 1 ? A0 : (q == 2 ? E2A : E3A)), EB = q == 0 ? 0.f : (q == 1 ? B0 : (q == 2 ? E2B : E3B));
        float Hin = 0.f;
        if (c > 0) {
            GAS unsigned long long* gp = (GAS unsigned long long*)gran + ((size_t)b * NCHUNK + (c - 1)) * W + chl;
            unsigned long long x = xi_pre; unsigned spins = 0;
            for (;;) { if (spins) x = __hip_atomic_load(gp, __ATOMIC_RELAXED, __HIP_MEMORY_SCOPE_AGENT);
                const bool ok = (unsigned)(x >> 32) == epoch;
                if (__all(ok)) break;
                __builtin_amdgcn_s_sleep(1);
                if (++spins > (1u << 16)) break; }
            Hin = __builtin_bit_cast(float, (unsigned)x);
        }
        if (c < NCHUNK - 1 && q == 0) {
            const float Hout = TB + TA * Hin;
            __hip_atomic_store((GAS unsigned long long*)gran + ((size_t)b * NCHUNK + c) * W + chl, ((unsigned long long)epoch << 32) | (unsigned long long)__builtin_bit_cast(unsigned, Hout), __ATOMIC_RELAXED, __HIP_MEMORY_SCOPE_AGENT);
        }
        const float Hq = EB + EA * Hin;
#pragma unroll
        for (int m = 0; m < 16; ++m)
#pragma unroll
            for (int i = 0; i < 4; ++i)
            { LAS unsigned short* yp = (LAS unsigned short*)(gel + (16 * m + i) * XP);
                *yp = (unsigned short)(pk2(__builtin_fmaf((i & 1) ? bfhi(ps[m][i >> 1]) : bflo(ps[m][i >> 1]), Hq, bf2f(*yp)), 0.f) & 0xffffu); }
        __syncthreads();
        {   const int ch = 128 * h + 8 * cgp, tl0 = 8 * tg;
#pragma unroll
            for (int t = 0; t < 8; ++t) { const int tl = tl0 + t, R = 16 * ((tl >> 2) & 15) + 4 * (tl >> 6) + (tl & 3);
                *(GAS v4u*)(Y + (grow0 + tl) * (size_t)W + ch) = *(const LAS v4u*)(gts + R * XP + 16 * cgp); } }
        __syncthreads();
    }
}

__device__ __forceinline__ void final_phase(const bf16* x16, float* xo, const float* part, const float* fg, int gw, int NGW, int lane) {
    f32x4 g[4];
#pragma unroll
    for (int jj = 0; jj < 4; ++jj) g[jj] = *((const GAS f32x4*)fg + lane + 64 * jj);
    for (int m = gw; m < T; m += NGW) {
        float s = (lane < 16) ? *(const GAS float*)(part + (size_t)m * 16 + lane) : 0.f;
        s = wave_sum(s);
        const float inv = __builtin_amdgcn_rsqf(s * (1.0f / D) + EPS);
        const GAS v2u* xi = (const GAS v2u*)(x16 + (size_t)m * D) + lane;
        GAS f32x4* xr = (GAS f32x4*)(xo + (size_t)m * D) + lane;
#pragma unroll
        for (int jj = 0; jj < 4; ++jj) { const v2u u = __builtin_nontemporal_load(xi + 64 * jj); const f32x4 v = {bflo(u.x), bfhi(u.x), bflo(u.y), bfhi(u.y)}; __builtin_nontemporal_store(v * inv * g[jj], xr + 64 * jj); }
    }
}

constexpr int N_PHASES = 16;
__global__ void __launch_bounds__(NWAVES * 64, 2) trunk_fwd(Args args) {
    extern __shared__ __attribute__((aligned(16))) unsigned char lds_raw[];
    LAS unsigned char* lds = (LAS unsigned char*)lds_raw;
    cg::grid_group grid = cg::this_grid();
    const int tid = threadIdx.x, lane = tid & 63, wave = __builtin_amdgcn_readfirstlane(tid >> 6);
    const int G = gridDim.x, gw = blockIdx.x * NWAVES + wave, NGW = G * NWAVES;
    const int lo = args.ph_lo, hi = args.ph_hi;
    unsigned char* ws = args.ws;
    bf16* X16 = (bf16*)(ws + WS_X16); bf16* U = (bf16*)(ws + WS_U); bf16* Y = (bf16*)(ws + WS_Y);
    float* part = (float*)(ws + WS_PART);
#define IN(k) (lo <= (k) && (k) < hi)
    if (tid < 2) ((volatile LAS unsigned*)(lds + MISC_OFF))[tid] = 0u;
    __syncthreads();
    XcdBarrier bar = xcd_barrier_post((unsigned*)(ws + WS_CTL), (volatile LAS unsigned*)(lds + MISC_OFF));
#define SEAM(k) do { if (IN(k) && IN((k) + 1)) { xcd_barrier(bar); } } while (0)
    if (args.ph_hi > 1000) grid.sync();
    if (IN(0)) { prologue(args, lds, gw, NGW, lane, wave); }
    SEAM(0);
    for (int l = 0; l < 4; ++l) {
        const int jl = l >> 1, base = 1 + 7 * jl + ((l & 1) ? 4 : 0);
        if (!(l & 1)) {
            if (IN(base)) {
                pg8::Gemm g{X16, (const bf16*)(ws + WS_WINA) + (size_t)jl * 2 * W * D, T, 2 * W, D}; pg8::StaticOrder S; S.init(T, 2 * W, G, (int)blockIdx.x);
                LAS float* invt = (LAS float*)(lds + 131072);
                { pg8::Unit f0, f1, f2; for (int ui = 0; S.next(ui, f0); ui += 3) { const bool h1 = S.next(ui + 1, f1), h2 = S.next(ui + 2, f2);
                      pg8::fill_inv_table3(invt, ui, f0.pm, h1 ? f1.pm : f0.pm, h2 ? f2.pm : f0.pm, h1, h2, part); } }
                __syncthreads();
                pg8::EpiInA E{U, invt, 0};
                pg8::gemm_phase<pg8::EpiInA, pg8::StaticOrder, true, true>(lds, g, S, E);
            }
            SEAM(base);
            const bf16* GWl = (const bf16*)(ws + WS_GW) + (size_t)jl * NH * 256 * 128;
            const float* gate_b = args.in[6] + (size_t)jl * NH * 256; const float* cw = args.in[3] + (size_t)jl * 4 * W; const float* cb = args.in[4] + (size_t)jl * W;
            const float* sp = (const float*)(ws + WS_SP) + (size_t)jl * W;
            if (IN(base + 2)) scan_single(lds, U, Y, GWl, gate_b, cw, cb, sp, (unsigned long long*)(ws + WS_GRAN), (unsigned)(jl + 1));
            SEAM(base + 2);
        } else {
            if (IN(base)) {
                pg8::Gemm g{X16, (const bf16*)(ws + WS_WINB) + (size_t)jl * 4 * W * D, T, 4 * W, D}; pg8::StaticOrder S; S.init(T, 4 * W, G, (int)blockIdx.x);
                LAS float* invt = (LAS float*)(lds + 131072);
                { pg8::Unit f0, f1, f2; for (int ui = 0; S.next(ui, f0); ui += 3) { const bool h1 = S.next(ui + 1, f1), h2 = S.next(ui + 2, f2);
                      pg8::fill_inv_table3(invt, ui, f0.pm, h1 ? f1.pm : f0.pm, h2 ? f2.pm : f0.pm, h1, h2, part); } }
                __syncthreads();
                pg8::EpiInB E{Y, invt, args.in[10] + (size_t)jl * 3 * W, (float*)(ws + WS_PH), (float*)(ws + WS_QH), (float*)(ws + WS_CHH), 0};
                pg8::gemm_phase<pg8::EpiInB, pg8::StaticOrder, true, true>(lds, g, S, E);
            }
            SEAM(base);
        }
        const int po = base + ((l & 1) ? 2 : 3);
        if (IN(po)) {
            const bf16* wo = (l & 1) ? (const bf16*)(ws + WS_WOUTB) + (size_t)jl * D * W : (const bf16*)(ws + WS_WOUTA) + (size_t)jl * D * W;
            pg8::Gemm g{Y, wo, T, D, W}; pg8::StaticOrder S; S.init(T, D, G, (int)blockIdx.x);
            if (l & 1) { pg8::Unit fu; for (int ui = 0; S.next(ui, fu); ++ui) pg8::convb_fixup(fu.pm, Y, args.in[10] + (size_t)jl * 3 * W, (const float*)(ws + WS_PH), (const float*)(ws + WS_QH), (const float*)(ws + WS_CHH));
                asm volatile("s_waitcnt vmcnt(0)" ::: "memory"); __syncthreads(); }
            pg8::EpiOut E{X16, part};
            pg8::gemm_phase<pg8::EpiOut, pg8::StaticOrder, true, true>(lds, g, S, E);
        }
        SEAM(po);
    }
    if (IN(15)) final_phase(X16, args.out, part, args.in[12], gw, NGW, lane);
#undef IN
#undef SEAM
}

extern "C" void kernel_launch(void* const* d_in, const int* in_sizes, int n_in, void* d_out, int out_size, void* d_ws, size_t ws_size, hipStream_t stream) {
    static int grid = 0;
    if (grid == 0) {
        if (n_in != 13 || in_sizes[0] != T * D || out_size != T * D || ws_size < WS_END) { fprintf(stderr, "kernel_launch: unexpected shapes (n_in %d, in0 %d, out %d, ws %zu); nothing launched\n", n_in, n_in > 0 ? in_sizes[0] : -1, out_size, ws_size); grid = -1; return; }
        int dev = 0, cus = 0, per_cu = 0;
        if (hipGetDevice(&dev) != hipSuccess || hipDeviceGetAttribute(&cus, hipDeviceAttributeMultiprocessorCount, dev) != hipSuccess) { grid = -1; return; }
        if (hipFuncSetAttribute((const void*)trunk_fwd, hipFuncAttributeMaxDynamicSharedMemorySize, LDS_BYTES) != hipSuccess) { fprintf(stderr, "kernel_launch: hipFuncSetAttribute failed\n"); grid = -1; return; }
        if (hipOccupancyMaxActiveBlocksPerMultiprocessor(&per_cu, (const void*)trunk_fwd, NWAVES * 64, LDS_BYTES) != hipSuccess || per_cu < 1) { fprintf(stderr, "kernel_launch: occupancy query gave %d\n", per_cu); per_cu = 1; }
        (void)hipGetLastError();
        grid = cus * 1;
    }
    if (grid < 0) return;
    if (hipMemsetAsync((char*)d_ws + WS_CTL, 0, CTL_BYTES, stream) != hipSuccess) { fprintf(stderr, "kernel_launch: memset failed\n"); return; }
    Args a{};
    for (int i = 0; i < 13; ++i) a.in[i] = (const float*)d_in[i];
    a.out = (float*)d_out; a.ws = (unsigned char*)d_ws;
    a.ph_lo = 0; a.ph_hi = N_PHASES;
    void* kargs[] = {&a};
    const hipError_t e = hipLaunchCooperativeKernel((const void*)trunk_fwd, dim3(grid), dim3(NWAVES * 64), kargs, LDS_BYTES, stream);
    if (e != hipSuccess) fprintf(stderr, "kernel_launch: cooperative launch failed: %s (grid %d)\n", hipGetErrorString(e), grid);
}
```
